# Optimizing an MI355X kernel written in HIP

```python
import jax, jax.numpy as jnp
from jax import lax
import numpy as np

D_MODEL = 1024
BATCH = 16
SEQ = 2048
DEPTH = 2

HEAD_DIM = 64
N_HEADS = D_MODEL // HEAD_DIM
HEADS_A = (N_HEADS * 3) // 8
HEADS_B = N_HEADS // 4
HEADS_C = N_HEADS - HEADS_A - HEADS_B
D_A = HEADS_A * HEAD_DIM
D_B = HEADS_B * HEAD_DIM
D_C = HEADS_C * HEAD_DIM
D_MIX = D_A + D_B + D_C
D_PROJ = 2 * D_A + 2 * D_B + 3 * D_C
CONV_A_WIDTH = 31
CONV_C_WIDTH = 3
CHUNK = 128
D_FF = 128 * ((8 * D_MODEL // 3 + 127) // 128)
RMS_EPS = 1e-6
LN_EPS = 1e-5
SPLITS = [int(s) for s in np.cumsum([D_A, D_A, D_B, D_B, D_C, D_C, D_C])[:-1]]

kernel_name = "hybrid_conformer_gmlp_shortconv_macaron"


def rms_norm(x, g):
    xf = x.astype(jnp.float32)
    y = xf * lax.rsqrt(jnp.mean(xf * xf, axis=-1, keepdims=True) + RMS_EPS)
    return (y * g.astype(jnp.float32)).astype(x.dtype)


def layer_norm(x, g, b):
    xf = x.astype(jnp.float32)
    mu = jnp.mean(xf, axis=-1, keepdims=True)
    xc = xf - mu
    var = jnp.mean(xc * xc, axis=-1, keepdims=True)
    y = xc * lax.rsqrt(var + LN_EPS) * g.astype(jnp.float32) + b.astype(jnp.float32)
    return y.astype(x.dtype)


def causal_depthwise_conv(x, w):
    k, c = w.shape
    return lax.conv_general_dilated(
        x, w[:, None, :].astype(x.dtype), window_strides=(1,), padding=[(k - 1, 0)],
        dimension_numbers=("NWC", "WIO", "NWC"), feature_group_count=c)


def swiglu_ffn(h, w_gate, w_up, w_down):
    return (jax.nn.silu(h @ w_gate) * (h @ w_up)) @ w_down


def chunked_spatial_gating(u, v, ln_g, ln_b, w_s, b_s):
    bsz, seq, _ = v.shape
    v = layer_norm(v, ln_g, ln_b)
    v = v.reshape(bsz, seq // CHUNK, CHUNK, HEADS_B, HEAD_DIM)
    mask = jnp.tril(jnp.ones((CHUNK, CHUNK), dtype=bool))
    w = jnp.where(mask, w_s, 0).astype(v.dtype)
    s = jnp.einsum("hts,bcshd->bcthd", w, v) + b_s.T.astype(v.dtype)[None, None, :, :, None]
    return u * s.reshape(bsz, seq, D_B)


def setup_inputs(seed: int = 0) -> dict:
    key = jax.random.key(seed)
    ks = jax.random.split(key, 24)
    f32 = jnp.float32

    def nrm(k, shape, scale):
        return jax.random.normal(k, shape, f32) * scale

    def gain(k, shape):
        return 1.0 + 0.02 * jax.random.normal(k, shape, f32)

    L = DEPTH
    return {
        "x": jax.random.normal(ks[0], (BATCH, SEQ, D_MODEL), f32),
        "ffn1_norm": gain(ks[1], (L, D_MODEL)),
        "ffn1_w_gate": nrm(ks[2], (L, D_MODEL, D_FF), D_MODEL ** -0.5),
        "ffn1_w_up": nrm(ks[3], (L, D_MODEL, D_FF), D_MODEL ** -0.5),
        "ffn1_w_down": nrm(ks[4], (L, D_FF, D_MODEL), D_FF ** -0.5),
        "mix_norm": gain(ks[5], (L, D_MODEL)),
        "w_in": nrm(ks[6], (L, D_MODEL, D_PROJ), D_MODEL ** -0.5),
        "conv_a_w": nrm(ks[7], (L, CONV_A_WIDTH, D_A), CONV_A_WIDTH ** -0.5),
        "conv_a_b": nrm(ks[8], (L, D_A), 0.02),
        "ln_a_g": gain(ks[9], (L, D_A)),
        "ln_a_b": nrm(ks[10], (L, D_A), 0.02),
        "ln_v_g": gain(ks[11], (L, D_B)),
        "ln_v_b": nrm(ks[12], (L, D_B), 0.02),
        "w_s": nrm(ks[13], (L, HEADS_B, CHUNK, CHUNK), CHUNK ** -0.5),
        "b_s": gain(ks[14], (L, HEADS_B, CHUNK)),
        "conv_c_w": nrm(ks[15], (L, CONV_C_WIDTH, D_C), CONV_C_WIDTH ** -0.5),
        "w_out": nrm(ks[16], (L, D_MIX, D_MODEL), D_MIX ** -0.5),
        "ffn2_norm": gain(ks[17], (L, D_MODEL)),
        "ffn2_w_gate": nrm(ks[18], (L, D_MODEL, D_FF), D_MODEL ** -0.5),
        "ffn2_w_up": nrm(ks[19], (L, D_MODEL, D_FF), D_MODEL ** -0.5),
        "ffn2_w_down": nrm(ks[20], (L, D_FF, D_MODEL), D_FF ** -0.5),
        "final_norm": gain(ks[21], (D_MODEL,)),
    }


def reference(x, ffn1_norm, ffn1_w_gate, ffn1_w_up, ffn1_w_down, mix_norm, w_in,
              conv_a_w, conv_a_b, ln_a_g, ln_a_b, ln_v_g, ln_v_b, w_s, b_s, conv_c_w,
              w_out, ffn2_norm, ffn2_w_gate, ffn2_w_up, ffn2_w_down, final_norm):
    for l in range(DEPTH):
        h = rms_norm(x, ffn1_norm[l])
        x = x + 0.5 * swiglu_ffn(h, ffn1_w_gate[l], ffn1_w_up[l], ffn1_w_down[l])

        h = rms_norm(x, mix_norm[l])
        p = h @ w_in[l]
        a_val, a_gate, b_u, b_v, c_b, c_c, c_x = jnp.split(p, SPLITS, axis=-1)

        a = a_val * jax.nn.sigmoid(a_gate)
        a = causal_depthwise_conv(a, conv_a_w[l]) + conv_a_b[l]
        a = jax.nn.silu(layer_norm(a, ln_a_g[l], ln_a_b[l]))

        b = chunked_spatial_gating(jax.nn.gelu(b_u), jax.nn.gelu(b_v),
                                   ln_v_g[l], ln_v_b[l], w_s[l], b_s[l])

        c = c_b * causal_depthwise_conv(c_c * c_x, conv_c_w[l])

        x = x + jnp.concatenate([a, b, c], axis=-1) @ w_out[l]

        h = rms_norm(x, ffn2_norm[l])
        x = x + 0.5 * swiglu_ffn(h, ffn2_w_gate[l], ffn2_w_up[l], ffn2_w_down[l])
    return rms_norm(x, final_norm)
```

```cpp
#include <hip/hip_runtime.h>
#include <hip/hip_cooperative_groups.h>
#include <cstdio>
#include <cstdint>
namespace cg = cooperative_groups;

#ifndef MK_N_LAUNCHES
#define MK_N_LAUNCHES 1
#endif
#ifndef MK_CG_SYNC
#define MK_CG_SYNC 0
#endif

#ifndef PROBE_GU
#define PROBE_GU 0
#endif
#ifndef PROBE_NULLGU
#define PROBE_NULLGU 0
#endif
#ifndef PROBE_FIXGU
#define PROBE_FIXGU 0
#endif
#ifndef PROBE_X
#define PROBE_X 0
#endif
#ifndef PROBE_D
#define PROBE_D 0
#endif
#ifndef PROBE_IN
#define PROBE_IN 0
#endif
#ifndef PROBE_OUT
#define PROBE_OUT 0
#endif
#ifndef PROBE_MIX
#define PROBE_MIX 0
#endif
#ifndef PROBE_PRO
#define PROBE_PRO 0
#endif
#ifndef PROBE_FIN
#define PROBE_FIN 0
#endif

constexpr int NWAVES = 8;
constexpr int BATCH = 16, SEQ = 2048, M = BATCH * SEQ, D = 1024, FF = 2816, NGU = 2 * FF, DPROJ = 2432, NIN = 2560, DEPTH = 2;
constexpr int DA = 384, DB = 256, DC = 384, PACT_W = 1664, CHUNK = 128, NCHUNK = M / CHUNK;
constexpr int P_GLU = 0, P_GU = 384, P_GV = 640, P_CX = 896, P_CB = 1280;
constexpr int MIX_A = 0, MIX_B = 384, MIX_C = 640;
constexpr float RMS_EPS = 1e-6f, LN_EPS = 1e-5f;
constexpr int N_PHASES = 16;

namespace pg8 {
#define PG8_LAS __attribute__((address_space(3)))
typedef unsigned short bf16_t;
typedef short bf16x8 __attribute__((ext_vector_type(8)));
typedef float f32x4 __attribute__((ext_vector_type(4)));
typedef unsigned u32x4 __attribute__((ext_vector_type(4)));
constexpr int BM = 256, BK = 64, HALF = 128, HTB = HALF * BK * 2  , STAGE_BYTES = 8 * HTB, NXCD = 8, WGM = 8;

__host__ __device__ __forceinline__ int lds_byte(int r, int c) { const int st = (r >> 4) * 2 + (c >> 5), rr = r & 15, cc = c & 31, ob = rr * 64 + cc * 2; return st * 1024 + (ob ^ (((ob >> 9) & 1) << 5)); }
__host__ __device__ __forceinline__ void stage_rc(int b, int& R, int& C) { const int st = b / 1024, sb = b % 1024, swz = sb ^ (((sb >> 9) & 1) << 5); R = (st >> 1) * 16 + swz / 64; C = (st & 1) * 32 + (swz % 64) / 2; }
__host__ __device__ __forceinline__ int perm32(int rho) { const int n = rho >> 4, i = rho & 15; return 8 * (i >> 2) + 4 * n + (i & 3); }

struct Unit { int pm, pn; };
struct Gemm { const bf16_t* A; const bf16_t* Bt; int M, N, K; };

struct StaticOrder {
    int nM, nN, nwg, G, c;
    __host__ __device__ void init(int M, int N, int G_, int c_) { nM = M / BM; nN = N / BM; nwg = nM * nN; G = G_; c = c_; }
    __host__ __device__ bool next(int i, Unit& u) const {
        const long L = (long)i * G + c; if (L >= nwg) return false;
        int wgid = (int)L; { const int q = nwg / NXCD, r = nwg % NXCD, xcd = wgid % NXCD, off = wgid / NXCD; wgid = (xcd < r ? xcd * (q + 1) : r * (q + 1) + (xcd - r) * q) + off; }
        const int nig = WGM * nN, gid = wgid / nig, fm = gid * WGM, gsz = (nM - fm) < WGM ? (nM - fm) : WGM;
        u.pm = fm + ((wgid % nig) % gsz); u.pn = (wgid % nig) / gsz; return true;
    }
    __device__ __forceinline__ void a_ready(const Unit&) const {}
    __device__ __forceinline__ void done(const Unit&) const {}
};

__device__ __forceinline__ unsigned cvt_pk_bf16(float lo, float hi) { unsigned r; asm volatile("v_cvt_pk_bf16_f32 %0, %1, %2" : "=v"(r) : "v"(lo), "v"(hi)); return r; }
__device__ __forceinline__ float sigmoid_f(float x) { return __builtin_amdgcn_rcpf(1.0f + __builtin_amdgcn_exp2f(-1.4426950408889634f * x)); }
__device__ __forceinline__ float gelu_tanh_f(float x) { const float z = x * (1.5957691216057308f + 0.07135481282817f * x * x); return x * sigmoid_f(z); }
__device__ __forceinline__ u32x4 pack8(const f32x4 a, const f32x4 b) { u32x4 w; w.x = cvt_pk_bf16(a[0], a[1]); w.y = cvt_pk_bf16(a[2], a[3]); w.z = cvt_pk_bf16(b[0], b[1]); w.w = cvt_pk_bf16(b[2], b[3]); return w; }
#define PG8_GAS __attribute__((address_space(1)))
__device__ __forceinline__ f32x4 exp4(const f32x4 t) { f32x4 e; e[0] = __builtin_amdgcn_exp2f(t[0]); e[1] = __builtin_amdgcn_exp2f(t[1]); e[2] = __builtin_amdgcn_exp2f(t[2]); e[3] = __builtin_amdgcn_exp2f(t[3]); return e; }
__device__ __forceinline__ f32x4 rcp4(const f32x4 t) { f32x4 e; e[0] = __builtin_amdgcn_rcpf(t[0]); e[1] = __builtin_amdgcn_rcpf(t[1]); e[2] = __builtin_amdgcn_rcpf(t[2]); e[3] = __builtin_amdgcn_rcpf(t[3]); return e; }
__device__ __forceinline__ f32x4 gelu4(const f32x4 x) { const f32x4 z = x * (x * x * -0.10294324f + -2.3022082f); return x * rcp4(exp4(z) + 1.0f); }
__device__ __forceinline__ float rs_of(float ss) { return __builtin_amdgcn_rsqf(ss * (1.0f / 1024.0f) + 1e-6f); }
__device__ __forceinline__ void load_rs(const float* rowss, int row0, float (&rs)[2][4]) {
    const PG8_GAS float* p = (const PG8_GAS float*)rowss + row0;
#pragma unroll
    for (int ai = 0; ai < 2; ++ai)
#pragma unroll
        for (int m = 0; m < 4; ++m) rs[ai][m] = p[ai * HALF + m * 16];
#pragma unroll
    for (int ai = 0; ai < 2; ++ai)
#pragma unroll
        for (int m = 0; m < 4; ++m) rs[ai][m] = rs_of(rs[ai][m]);
}

__device__ __forceinline__ void dma_rowss(const float* rowss, PG8_LAS float* tbl, int pm, int wid, int lane) {
    if (wid < 4) __builtin_amdgcn_global_load_lds((const unsigned*)(rowss + (size_t)pm * BM + wid * 64 + lane), (PG8_LAS unsigned*)(tbl + wid * 64), 4, 0, 0);
}
__device__ __forceinline__ void load_rs_lds(const PG8_LAS float* tbl, int wr, int fr, float (&rs)[2][4]) {
#pragma unroll
    for (int ai = 0; ai < 2; ++ai)
#pragma unroll
        for (int m = 0; m < 4; ++m) rs[ai][m] = rs_of(tbl[ai * HALF + wr * 64 + m * 16 + fr]);
}
struct EpiSwiGLU {
    static constexpr bool PERM = true, AFTER_DRAIN = false;
    bf16_t* H; const float* rowss; int ldh; PG8_LAS float* tbl;
    __device__ __forceinline__ void prefetch(const Unit& u, int wid, int lane) const { dma_rowss(rowss, tbl, u.pm, wid, lane); }
    __device__ __forceinline__ void operator()(const f32x4 (&acc)[2][2][4][2], const Unit& u, int wr, int wc, int fr, int fq) const {
        const int row0 = u.pm * BM + wr * 64 + fr, col0 = u.pn * HALF + wc * 32 + 8 * fq;
        float rsv[2][4]; load_rs_lds(tbl, wr, fr, rsv);
        PG8_GAS bf16_t* hp = (PG8_GAS bf16_t*)H + (size_t)row0 * ldh + col0;
#pragma unroll
        for (int ai = 0; ai < 2; ++ai)
#pragma unroll
            for (int m = 0; m < 4; ++m) { const float rs = rsv[ai][m], c1 = -1.4426950408889634f * rs, rs2 = rs * rs;
                f32x4 o[2];
#pragma unroll
                for (int n = 0; n < 2; ++n) { const f32x4 g = acc[ai][0][m][n], t = g * c1; f32x4 e;
#pragma unroll
                    for (int j = 0; j < 4; ++j) e[j] = __builtin_amdgcn_exp2f(t[j]);
                    const f32x4 den = e + 1.0f; f32x4 r;
#pragma unroll
                    for (int j = 0; j < 4; ++j) r[j] = __builtin_amdgcn_rcpf(den[j]);
                    o[n] = (g * acc[ai][1][m][n]) * (r * rs2); }
                *(PG8_GAS u32x4*)(hp + (size_t)(ai * HALF + m * 16) * ldh) = pack8(o[0], o[1]); }
    }
};
__device__ __forceinline__ float bf_lo(unsigned w) { return __uint_as_float(w << 16); }
__device__ __forceinline__ float bf_hi(unsigned w) { return __uint_as_float(w & 0xffff0000u); }
struct EpiResid {
    static constexpr bool PERM = true, AFTER_DRAIN = false;
    bf16_t* xb; float* rowss; float scale; int live;
    __device__ __forceinline__ void prefetch(const Unit&, int, int) const {}
    __device__ __forceinline__ void operator()(const f32x4 (&acc)[2][2][4][2], const Unit& u, int wr, int wc, int fr, int fq) const {
        const int row0 = u.pm * BM + wr * 64 + fr, col0 = u.pn * BM + wc * 32 + 8 * fq;
        PG8_GAS bf16_t* xp = (PG8_GAS bf16_t*)xb + (size_t)row0 * 1024 + col0; PG8_GAS float* sp = (PG8_GAS float*)rowss + row0;
#pragma unroll
        for (int ai = 0; ai < 2; ++ai) {
            u32x4 x[4][2];
#pragma unroll
            for (int m = 0; m < 4; ++m)
#pragma unroll
                for (int bj = 0; bj < 2; ++bj) x[m][bj] = *(const PG8_GAS u32x4*)(xp + (size_t)(ai * HALF + m * 16) * 1024 + bj * HALF);
#pragma unroll
            for (int m = 0; m < 4; ++m) { float ss = 0.f;
#pragma unroll
                for (int bj = 0; bj < 2; ++bj) { const float sc = live ? scale : 0.f; const f32x4 a0 = acc[ai][bj][m][0] * sc, a1 = acc[ai][bj][m][1] * sc; const u32x4 xv = x[m][bj]; f32x4 v0, v1;
                    v0[0] = bf_lo(xv[0]) + a0[0]; v0[1] = bf_hi(xv[0]) + a0[1]; v0[2] = bf_lo(xv[1]) + a0[2]; v0[3] = bf_hi(xv[1]) + a0[3];
                    v1[0] = bf_lo(xv[2]) + a1[0]; v1[1] = bf_hi(xv[2]) + a1[1]; v1[2] = bf_lo(xv[3]) + a1[2]; v1[3] = bf_hi(xv[3]) + a1[3];
                    *(PG8_GAS u32x4*)(xp + (size_t)(ai * HALF + m * 16) * 1024 + bj * HALF) = pack8(v0, v1);
                    ss += (v0[0] * v0[0] + v0[1] * v0[1]) + (v0[2] * v0[2] + v0[3] * v0[3]) + (v1[0] * v1[0] + v1[1] * v1[1]) + (v1[2] * v1[2] + v1[3] * v1[3]); }
                ss += __shfl_xor(ss, 16); ss += __shfl_xor(ss, 32);
                if (fq == 0 && live) (void)__builtin_amdgcn_global_atomic_fadd_f32(sp + ai * HALF + m * 16, ss); }
        }
    }
};
struct EpiIn {
    static constexpr bool PERM = true, AFTER_DRAIN = false;
    bf16_t* P; const float* rowss; PG8_LAS float* tbl;
    __device__ __forceinline__ void prefetch(const Unit& u, int wid, int lane) const { dma_rowss(rowss, tbl, u.pm, wid, lane); }
    __device__ __forceinline__ void operator()(const f32x4 (&acc)[2][2][4][2], const Unit& u, int wr, int wc, int fr, int fq) const {
        const int row0 = u.pm * BM + wr * 64 + fr, cw = wc * 32 + 8 * fq, pn = u.pn;
        float rsv[2][4]; load_rs_lds(tbl, wr, fr, rsv);
        PG8_GAS bf16_t* pp = (PG8_GAS bf16_t*)P + (size_t)row0 * 1664 + cw;
#pragma unroll
        for (int ai = 0; ai < 2; ++ai)
#pragma unroll
            for (int m = 0; m < 4; ++m) { const float rs = rsv[ai][m];
                PG8_GAS bf16_t* rp = pp + (size_t)(ai * HALF + m * 16) * 1664;
                const f32x4 A0 = acc[ai][0][m][0], A1 = acc[ai][0][m][1], B0 = acc[ai][1][m][0], B1 = acc[ai][1][m][1];
                if (pn < 3) { const float c1 = -1.4426950408889634f * rs;
                    *(PG8_GAS u32x4*)(rp + 0 + pn * HALF) = pack8(A0 * (rcp4(exp4(B0 * c1) + 1.0f) * rs), A1 * (rcp4(exp4(B1 * c1) + 1.0f) * rs));
                } else if (pn < 5) {
                    *(PG8_GAS u32x4*)(rp + 384 + (pn - 3) * BM) = pack8(gelu4(A0 * rs), gelu4(A1 * rs)); *(PG8_GAS u32x4*)(rp + 384 + (pn - 3) * BM + HALF) = pack8(gelu4(B0 * rs), gelu4(B1 * rs));
                } else if (pn < 8) { const float rs2 = rs * rs;
                    *(PG8_GAS u32x4*)(rp + 896 + (pn - 5) * HALF) = pack8(A0 * B0 * rs2, A1 * B1 * rs2);
                } else if (pn == 8) {
                    *(PG8_GAS u32x4*)(rp + 1280) = pack8(A0 * rs, A1 * rs); *(PG8_GAS u32x4*)(rp + 1280 + HALF) = pack8(B0 * rs, B1 * rs);
                } else {
                    *(PG8_GAS u32x4*)(rp + 1280 + BM) = pack8(A0 * rs, A1 * rs);
                } }
    }
};

struct EpiNull {
    static constexpr bool PERM = true, AFTER_DRAIN = false;
    __device__ __forceinline__ void prefetch(const Unit&, int, int) const {}
    __device__ __forceinline__ void operator()(const f32x4 (&acc)[2][2][4][2], const Unit& u, int wr, int wc, int fr, int fq) const {
#pragma unroll
        for (int ai = 0; ai < 2; ++ai)
#pragma unroll
            for (int bj = 0; bj < 2; ++bj)
#pragma unroll
                for (int m = 0; m < 4; ++m)
#pragma unroll
                    for (int n = 0; n < 2; ++n) asm volatile("" :: "v"(acc[ai][bj][m][n]));
    }
};

template <class Epi, class Sched, bool ALIGN_EPI = false, bool SP2 = false>
__device__ __forceinline__ void gemm_phase(PG8_LAS unsigned char* lds, const Gemm g, const Sched& S, const Epi& E) {
    int tid_ = threadIdx.x; asm volatile("" : "+v"(tid_)); const int tid = tid_, wid = __builtin_amdgcn_readfirstlane(tid >> 6), lane = tid & 63, wr = wid >> 2, wc = wid & 3, fr = lane & 15, fq = lane >> 4;
    const int K = g.K, nt = K / BK;
    unsigned voffA[2], voffB[2];
#pragma unroll
    for (int i = 0; i < 2; ++i) { int R, C; stage_rc(tid * 16 + i * 8192, R, C); const int Rb = Epi::PERM ? ((R & ~31) + perm32(R & 31)) : R;
        voffA[i] = (unsigned)(R * K + C) * 2u; voffB[i] = (unsigned)(Rb * K + C) * 2u; }
    const size_t kstep = (size_t)(BK * 2);
    const size_t hstep = (size_t)HALF * K * 2;
    const size_t tstep = 2 * hstep;
    const unsigned ldsw = (unsigned)wid * 1024u;
    const int aoff = lds_byte(wr * 64 + fr, fq * 8), boff = lds_byte(wc * 32 + fr, fq * 8);
#define PG8_SA(b, h) (((b) * 2 + (h)) * HTB)
#define PG8_SB(b, h) ((4 + (b) * 2 + (h)) * HTB)
#define PG8_STAGE(bufoff, gbase, voff) do { _Pragma("unroll") for (int _i = 0; _i < 2; ++_i) \
        __builtin_amdgcn_global_load_lds((const unsigned*)((const char*)(gbase) + (voff)[_i]), (PG8_LAS unsigned*)(lds + (bufoff) + ldsw + _i * 8192), 16, 0, 0); } while (0)
#define PG8_LDA(dst, b, h) do { _Pragma("unroll") for (int m = 0; m < 4; ++m) _Pragma("unroll") for (int k = 0; k < 2; ++k) dst[m][k] = *(const PG8_LAS bf16x8*)(lds + PG8_SA(b, h) + aoff + m * 2048 + k * 1024); } while (0)
#define PG8_LDB(dst, b, h) do { _Pragma("unroll") for (int n = 0; n < 2; ++n) _Pragma("unroll") for (int k = 0; k < 2; ++k) dst[n][k] = *(const PG8_LAS bf16x8*)(lds + PG8_SB(b, h) + boff + n * 2048 + k * 1024); } while (0)
#define PG8_MMA(ai, bj, At, Bt) do { __builtin_amdgcn_s_setprio(1); _Pragma("unroll") for (int m = 0; m < 4; ++m) _Pragma("unroll") for (int n = 0; n < 2; ++n) _Pragma("unroll") for (int k = 0; k < 2; ++k) \
        acc[ai][bj][m][n] = __builtin_amdgcn_mfma_f32_16x16x32_bf16(Bt[n][k], At[m][k], acc[ai][bj][m][n], 0, 0, 0); __builtin_amdgcn_s_setprio(0); } while (0)
#define PG8_WAIT_V(n) asm volatile("s_waitcnt vmcnt(" #n ")" ::: "memory")
#define PG8_WAIT_L(n) asm volatile("s_waitcnt lgkmcnt(" #n ")" ::: "memory")
#define PG8_BAR __builtin_amdgcn_s_barrier()
#define PG8_SCHED __builtin_amdgcn_sched_barrier(0)
    Unit cur, nxt; int ui = 0;
    if (!S.next(0, cur)) return;
    f32x4 acc[2][2][4][2];
#pragma unroll
    for (int a = 0; a < 2; ++a)
#pragma unroll
        for (int b = 0; b < 2; ++b)
#pragma unroll
            for (int m = 0; m < 4; ++m)
#pragma unroll
                for (int n = 0; n < 2; ++n) acc[a][b][m][n] = (f32x4){0.f, 0.f, 0.f, 0.f};
    bf16x8 At[4][2], B0[2][2], B1[2][2];
    const char* cA = (const char*)g.A + (size_t)cur.pm * tstep; const char* cB = (const char*)g.Bt + (size_t)cur.pn * tstep;
    S.a_ready(cur);
    if constexpr (SP2) {
        PG8_STAGE(PG8_SB(0, 0), cB, voffB); PG8_STAGE(PG8_SB(0, 1), cB + hstep, voffB); PG8_STAGE(PG8_SA(0, 0), cA, voffA); PG8_STAGE(PG8_SA(0, 1), cA + hstep, voffA);
        if (wr == 1) PG8_BAR;
        PG8_WAIT_V(2); PG8_BAR;
        PG8_STAGE(PG8_SB(1, 0), cB + kstep, voffB); PG8_STAGE(PG8_SA(1, 0), cA + kstep, voffA); PG8_STAGE(PG8_SB(1, 1), cB + hstep + kstep, voffB);
        PG8_WAIT_V(6); PG8_BAR;
    } else {
        PG8_STAGE(PG8_SB(0, 0), cB, voffB); PG8_STAGE(PG8_SA(0, 0), cA, voffA); PG8_STAGE(PG8_SB(0, 1), cB + hstep, voffB); PG8_STAGE(PG8_SA(0, 1), cA + hstep, voffA);
        if (wr == 1) PG8_BAR;
        PG8_WAIT_V(4); PG8_BAR;
        PG8_STAGE(PG8_SB(1, 0), cB + kstep, voffB); PG8_STAGE(PG8_SA(1, 0), cA + kstep, voffA); PG8_STAGE(PG8_SB(1, 1), cB + hstep + kstep, voffB);
        PG8_WAIT_V(6); PG8_BAR;
    }
    for (;;) {
        const bool has_next = S.next(ui + 1, nxt);
        const char* nA = has_next ? (const char*)g.A + (size_t)nxt.pm * tstep : cA; const char* nB = has_next ? (const char*)g.Bt + (size_t)nxt.pn * tstep : cB;
        for (int t = 0; t < nt; t += 2) {
            const bool last = (t == nt - 2);
            const char* a1 = cA + (size_t)(t + 1) * kstep;
            const char* a2 = last ? nA : cA + (size_t)(t + 2) * kstep; const char* b2 = last ? nB : cB + (size_t)(t + 2) * kstep;
            const char* a3 = a2 + kstep; const char* b3 = b2 + kstep;
            if (last && has_next) S.a_ready(nxt);
            if (last) E.prefetch(cur, wid, lane);
            if constexpr (SP2) {
            PG8_LDB(B0, 0, 0); PG8_LDB(B1, 0, 1); PG8_SCHED; PG8_LDA(At, 0, 0); PG8_STAGE(PG8_SA(1, 1), a1 + hstep, voffA);
            PG8_WAIT_V(8); PG8_WAIT_L(0); PG8_BAR; PG8_MMA(0, 0, At, B0); PG8_MMA(0, 1, At, B1); PG8_BAR; PG8_SCHED;
            PG8_LDA(At, 0, 1); PG8_STAGE(PG8_SB(0, 0), b2, voffB); PG8_STAGE(PG8_SB(0, 1), b2 + hstep, voffB); PG8_STAGE(PG8_SA(0, 0), a2, voffA);
            PG8_WAIT_V(8); PG8_WAIT_L(0); PG8_BAR; PG8_MMA(1, 0, At, B0); PG8_MMA(1, 1, At, B1); PG8_BAR; PG8_SCHED;
            PG8_LDB(B0, 1, 0); PG8_LDB(B1, 1, 1); PG8_SCHED; PG8_LDA(At, 1, 0); PG8_STAGE(PG8_SA(0, 1), a2 + hstep, voffA);
            PG8_WAIT_V(8); PG8_WAIT_L(0); PG8_BAR; PG8_MMA(0, 0, At, B0); PG8_MMA(0, 1, At, B1); PG8_BAR; PG8_SCHED;
            PG8_LDA(At, 1, 1); PG8_STAGE(PG8_SB(1, 0), b3, voffB); PG8_STAGE(PG8_SB(1, 1), b3 + hstep, voffB); PG8_STAGE(PG8_SA(1, 0), a3, voffA);
            PG8_WAIT_V(8); PG8_WAIT_L(0); PG8_BAR; PG8_MMA(1, 0, At, B0); PG8_MMA(1, 1, At, B1); PG8_BAR; PG8_SCHED;
            } else {
            PG8_LDB(B0, 0, 0); PG8_SCHED; PG8_LDA(At, 0, 0); PG8_STAGE(PG8_SA(1, 1), a1 + hstep, voffA);
            PG8_WAIT_L(8); PG8_BAR; PG8_WAIT_L(0); PG8_MMA(0, 0, At, B0); PG8_BAR; PG8_SCHED;
            PG8_LDB(B1, 0, 1); PG8_STAGE(PG8_SB(0, 0), b2, voffB);
            PG8_BAR; PG8_WAIT_L(0); PG8_MMA(0, 1, At, B1); PG8_BAR;
            PG8_LDA(At, 0, 1); PG8_STAGE(PG8_SA(0, 0), a2, voffA);
            PG8_BAR; PG8_WAIT_L(0); PG8_MMA(1, 0, At, B0); PG8_BAR; PG8_SCHED;
            PG8_STAGE(PG8_SB(0, 1), b2 + hstep, voffB);
            PG8_WAIT_V(6); PG8_BAR; PG8_MMA(1, 1, At, B1); PG8_BAR;
            PG8_LDB(B0, 1, 0); PG8_SCHED; PG8_LDA(At, 1, 0); PG8_STAGE(PG8_SA(0, 1), a2 + hstep, voffA);
            PG8_WAIT_L(8); PG8_BAR; PG8_WAIT_L(0); PG8_MMA(0, 0, At, B0); PG8_BAR; PG8_SCHED;
            PG8_LDB(B1, 1, 1); PG8_STAGE(PG8_SB(1, 0), b3, voffB);
            PG8_BAR; PG8_WAIT_L(0); PG8_MMA(0, 1, At, B1); PG8_BAR;
            PG8_LDA(At, 1, 1); PG8_STAGE(PG8_SA(1, 0), a3, voffA);
            PG8_BAR; PG8_WAIT_L(0); PG8_MMA(1, 0, At, B0); PG8_BAR; PG8_SCHED;
            PG8_STAGE(PG8_SB(1, 1), b3 + hstep, voffB);
            PG8_WAIT_V(6); PG8_BAR; PG8_MMA(1, 1, At, B1); PG8_BAR;
            }
        }
        if constexpr (ALIGN_EPI) { if (wr == 0) PG8_BAR; }
        if constexpr (!Epi::AFTER_DRAIN) { E(acc, cur, wr, wc, fr, fq); S.done(cur); }
        if (!has_next) break;
#pragma unroll
        for (int a = 0; a < 2; ++a)
#pragma unroll
            for (int b = 0; b < 2; ++b)
#pragma unroll
                for (int m = 0; m < 4; ++m)
#pragma unroll
                    for (int n = 0; n < 2; ++n) acc[a][b][m][n] = (f32x4){0.f, 0.f, 0.f, 0.f};
        cur = nxt; cA = nA; cB = nB; ++ui;
        if constexpr (ALIGN_EPI) { if (wr == 1) PG8_BAR; }
    }
    PG8_WAIT_V(0);
    if constexpr (!ALIGN_EPI) { if (wr == 0) PG8_BAR; }
    PG8_BAR;
    if constexpr (Epi::AFTER_DRAIN) { E.fused(acc, cur, wr, wc, fr, fq, lds, wid, lane); S.done(cur); }
#undef PG8_SA
#undef PG8_SB
#undef PG8_STAGE
#undef PG8_LDA
#undef PG8_LDB
#undef PG8_MMA
#undef PG8_WAIT_V
#undef PG8_WAIT_L
#undef PG8_BAR
#undef PG8_SCHED
}
}

#ifndef PG8_SP2
#define PG8_SP2 true
#endif
#ifndef PG8_ALIGN
#define PG8_ALIGN true
#endif

constexpr size_t MiB = 1u << 20;
constexpr size_t WS_CTL = 0, CTL_ZERO_BYTES = 64 * 1024;
constexpr size_t WS_ROWSS = 1 * MiB;
constexpr size_t WS_W = 2 * MiB, W_LAYER = 41 * MiB;
constexpr size_t WO_GU1 = 0, WO_D1 = 11 * MiB, WO_IN = 17 * MiB, WO_OUT = 22 * MiB, WO_GU2 = 24 * MiB, WO_D2 = 35 * MiB, WO_S = 40 * MiB + 512 * 1024, WO_RSW = WO_S + 4 * 128 * 128 * 2;
constexpr size_t WS_XB = 84 * MiB;
constexpr size_t WS_HID = 148 * MiB;
constexpr size_t WS_PACT = 148 * MiB, WS_MIX = 252 * MiB;
constexpr size_t WS_END = 324 * MiB;
static_assert(WO_D1 >= (size_t)NGU * D * 2 && WO_IN - WO_D1 >= (size_t)D * FF * 2 && WO_OUT - WO_IN >= (size_t)NIN * D * 2 && WO_S - WO_D2 >= (size_t)D * FF * 2 && WO_RSW + 4 * 128 * 4 <= W_LAYER, "weight map");
static_assert(WS_W + DEPTH * W_LAYER <= WS_XB && WS_XB + (size_t)M * D * 2 <= WS_HID && WS_HID + (size_t)M * FF * 2 <= WS_END && WS_PACT + (size_t)M * PACT_W * 2 <= WS_MIX && WS_MIX + (size_t)M * D * 2 <= WS_END, "d_ws map");
constexpr int CW_BAR = 1024;

constexpr int RING_OFF = 0, RING_BYTES = 131072;
constexpr int LDSCTL_OFF = RING_BYTES, MISC_OFF = LDSCTL_OFF + 320;
constexpr int RSTBL_OFF = RING_BYTES + 2048;
constexpr int LDS_BYTES = 163840;
static_assert(MISC_OFF + 128 <= LDS_BYTES, "LDS map");

#define GAS __attribute__((address_space(1)))
#define LAS __attribute__((address_space(3)))
typedef unsigned short bf16;
typedef unsigned v4u __attribute__((ext_vector_type(4)));
typedef unsigned v2u __attribute__((ext_vector_type(2)));
typedef float f32x4 __attribute__((ext_vector_type(4)));
typedef short bf16x8 __attribute__((ext_vector_type(8)));
typedef short s16x4 __attribute__((ext_vector_type(4)));
typedef GAS unsigned gu32;
#define RLX_AGENT __ATOMIC_RELAXED, __HIP_MEMORY_SCOPE_AGENT
#define LDS_WAIT() asm volatile("s_waitcnt lgkmcnt(0)" ::: "memory")
#define VM_WAIT() asm volatile("s_waitcnt vmcnt(0)" ::: "memory")
__device__ __forceinline__ unsigned f2bf(float f) { unsigned u = __builtin_bit_cast(unsigned, f); return (u + 0x7fffu + ((u >> 16) & 1u)) >> 16; }
__device__ __forceinline__ unsigned pk2(float lo, float hi) { return f2bf(lo) | (f2bf(hi) << 16); }
__device__ __forceinline__ float bflo(unsigned w) { return __uint_as_float(w << 16); }
__device__ __forceinline__ float bfhi(unsigned w) { return __uint_as_float(w & 0xffff0000u); }
__device__ __forceinline__ float sigm(float x) { return __builtin_amdgcn_rcpf(1.0f + __builtin_amdgcn_exp2f(-1.4426950408889634f * x)); }

#define XB_TMO      128
#define XB_XCNT(j)  (256  + 64 * (j))
#define XB_XSUB(j)  (1280 + 64 * (j))
#define XB_XGEN(j)  (2304 + 64 * (j))
#define XB_TOP      3328
#define XB_TOPGEN   3392
#define XCD_BAR_WORDS 3456
#define XB_SPIN_CAP (1u << 18)

__device__ __forceinline__ unsigned xb_ld(unsigned* p)              { return __hip_atomic_load(p, __ATOMIC_RELAXED, __HIP_MEMORY_SCOPE_AGENT); }
__device__ __forceinline__ unsigned xb_add(unsigned* p, unsigned v) { return __hip_atomic_fetch_add(p, v, __ATOMIC_RELAXED, __HIP_MEMORY_SCOPE_AGENT); }
__device__ __forceinline__ unsigned xb_xcc_id() { return (unsigned)__builtin_amdgcn_s_getreg((3 << 11) | 20) & 0xFu; }
#define XB_SPIN(cond, bar) do { unsigned _sp = 0; while (cond) { __builtin_amdgcn_s_sleep(1); \
    if ((++_sp & 255u) == 0u) { if (xb_ld(&(bar)[XB_TMO])) break; if (_sp > XB_SPIN_CAP) { atomicAdd(&(bar)[XB_TMO], 1u); break; } } } } while (0)

struct XcdBarrier {
    unsigned* bar; unsigned x;
    volatile LAS unsigned* st;
};

__device__ __forceinline__ XcdBarrier xcd_barrier_post(unsigned* bar, volatile LAS unsigned* st) {
    XcdBarrier b; b.bar = bar; b.x = xb_xcc_id(); b.st = st;
    if (threadIdx.x == 0) (void)xb_add(&bar[XB_XCNT(b.x)], 1u);
    return b;
}
__device__ __forceinline__ void xcd_barrier_complete(unsigned* bar, unsigned x, unsigned& nloc, unsigned& nx) {
    const unsigned G = gridDim.x * gridDim.y * gridDim.z;
    unsigned sum, cnt, mine, sp = 0u;
    for (;;) {
        sum = 0u; cnt = 0u; mine = 0u;
#pragma unroll
        for (unsigned j = 0; j < 16; ++j) { const unsigned c = xb_ld(&bar[XB_XCNT(j)]); sum += c; cnt += (c > 0u) ? 1u : 0u; mine = (j == x) ? c : mine; }
        if (sum == G) break;
        __builtin_amdgcn_s_sleep(1);
        if ((++sp & 255u) == 0u) { if (xb_ld(&bar[XB_TMO])) break; if (sp > XB_SPIN_CAP) { atomicAdd(&bar[XB_TMO], 1u); break; } }
    }
    nloc = mine > 0u ? mine : 1u; nx = cnt > 0u ? cnt : 1u;
}

__device__ __forceinline__ void xcd_barrier(const XcdBarrier& b) {
    asm volatile("s_waitcnt vmcnt(0)" ::: "memory");
    __syncthreads();
    if (threadIdx.x == 0) {
        unsigned* bar = b.bar;
        __builtin_amdgcn_s_waitcnt(0);
        unsigned nloc = b.st[0], nx = b.st[1];
        if (nloc == 0u) { xcd_barrier_complete(bar, b.x, nloc, nx); b.st[0] = nloc; b.st[1] = nx; }
        const unsigned old = xb_add(&bar[XB_XSUB(b.x)], 1u);
        const unsigned gen = old / nloc;
        if (old + 1u == (gen + 1u) * nloc) {
            __builtin_amdgcn_fence(__ATOMIC_RELEASE, "agent");
            asm volatile("s_waitcnt vmcnt(0)" ::: "memory");
            const unsigned og = xb_add(&bar[XB_TOP], 1u);
            const unsigned tg = og / nx;
            if (og + 1u == (tg + 1u) * nx) xb_add(&bar[XB_TOPGEN], 1u);
            else XB_SPIN(xb_ld(&bar[XB_TOPGEN]) == tg, bar);
            __builtin_amdgcn_fence(__ATOMIC_ACQUIRE, "agent");
            xb_add(&bar[XB_XGEN(b.x)], 1u);
            asm volatile("s_waitcnt vmcnt(0)" ::: "memory");
        } else {
            XB_SPIN(xb_ld(&bar[XB_XGEN(b.x)]) == gen, bar);
            __builtin_amdgcn_fence(__ATOMIC_ACQUIRE, "agent");
            asm volatile("s_waitcnt vmcnt(0)" ::: "memory");
        }
    }
    __syncthreads();
}

struct Frame {
    LAS unsigned char* lds;
    volatile LAS unsigned* MISC;
    gu32* ctl;
    int tid, lane, wave, G;
};
struct Args { const float* in[22]; float* out; unsigned char* ws; int ph_lo, ph_hi; };
#define LAUNDER_S(p) asm volatile("" : "+s"(p))
__device__ __forceinline__ float wave_sum(float v) {
#pragma unroll
    for (int o = 1; o < 64; o <<= 1) v += __shfl_xor(v, o);
    return v;
}
enum { I_X = 0, I_N1, I_G1, I_U1, I_D1, I_NM, I_WIN, I_CAW, I_CAB, I_LAG, I_LAB, I_LVG, I_LVB, I_WS, I_BS, I_CCW, I_WOUT, I_N2, I_G2, I_U2, I_D2, I_NF };

struct TItem { const float* W; const float* gain; bf16* WT; int N, K, dr, k0, n0; };
__device__ __forceinline__ void p0_item_load(const TItem& t, int lane, float (&v)[32]) {
    const GAS float* wp = (const GAS float*)t.W + (size_t)(t.k0 + (lane >> 5)) * t.N + t.n0 + (lane & 31);
#pragma unroll
    for (int i = 0; i < 32; ++i) { v[i] = *wp; wp += 2 * t.N; }
}
__device__ __forceinline__ void p0_item_finish(const TItem& t, LAS float* scr, int lane, const float (&v)[32]) {
    const int c = lane & 7;
    f32x4 g0 = (f32x4){1.f, 1.f, 1.f, 1.f}, g1 = g0;
    if (t.gain) { g0 = *(const GAS f32x4*)(t.gain + t.k0 + 8 * c); g1 = *(const GAS f32x4*)(t.gain + t.k0 + 8 * c + 4); }
#pragma unroll
    for (int i = 0; i < 32; ++i) scr[(2 * i + (lane >> 5)) * 33 + (lane & 31)] = v[i];
    LDS_WAIT(); asm volatile("" ::: "memory");
#pragma unroll
    for (int j = 0; j < 4; ++j) { const int n = (lane >> 3) + 8 * j; const LAS float* s = scr + (8 * c) * 33 + n;
        v4u o; o.x = pk2(s[0 * 33] * g0[0], s[1 * 33] * g0[1]); o.y = pk2(s[2 * 33] * g0[2], s[3 * 33] * g0[3]); o.z = pk2(s[4 * 33] * g1[0], s[5 * 33] * g1[1]); o.w = pk2(s[6 * 33] * g1[2], s[7 * 33] * g1[3]);
        *(GAS v4u*)(t.WT + (size_t)(t.dr + n) * t.K + t.k0 + 8 * c) = o; }
    LDS_WAIT(); asm volatile("" ::: "memory");
}
__device__ __forceinline__ int map_gu(int n0, int up) { return (n0 >> 7) * 256 + (n0 & 127) + (up ? 128 : 0); }
__device__ __forceinline__ int map_in(int n) {
    if (n < 384) return (n >> 7) * 256 + (n & 127);
    if (n < 768) { const int r = n - 384; return (r >> 7) * 256 + 128 + (r & 127); }
    if (n < 1280) return n;
    if (n < 1664) return 2048 + (n - 1280);
    if (n < 2048) { const int r = n - 1664; return 1280 + (r >> 7) * 256 + (r & 127); }
    { const int r = n - 2048; return 1280 + (r >> 7) * 256 + 128 + (r & 127); }
}
__device__ __forceinline__ void p0_prologue(Frame& F, const Args& A) {
    unsigned char* ws = A.ws; LAUNDER_S(ws);
    LAS float* scr = (LAS float*)(F.lds + RING_OFF + F.wave * 16384);
    const int gw = blockIdx.x * NWAVES + F.wave, NGW = F.G * NWAVES, lane = F.lane;
    constexpr int I_GU = (D / 64) * (FF / 32), I_DN = (FF / 64) * (D / 32), I_IN = (D / 64) * (DPROJ / 32), I_OUT = (D / 64) * (D / 32);
    constexpr int PER_LAYER = 4 * I_GU + 2 * I_DN + I_IN + I_OUT;
#define P0_DECODE(it_, T_) do { const int l = (it_) / PER_LAYER; int r = (it_) % PER_LAYER; unsigned char* wl = ws + WS_W + (size_t)l * W_LAYER; int mode; (T_).gain = nullptr; \
        if (r < I_GU) { (T_).W = A.in[I_G1] + (size_t)l * D * FF; (T_).gain = A.in[I_N1] + l * D; (T_).WT = (bf16*)(wl + WO_GU1); (T_).N = FF; (T_).K = D; mode = 1; } \
        else if ((r -= I_GU) < I_GU) { (T_).W = A.in[I_U1] + (size_t)l * D * FF; (T_).gain = A.in[I_N1] + l * D; (T_).WT = (bf16*)(wl + WO_GU1); (T_).N = FF; (T_).K = D; mode = 2; } \
        else if ((r -= I_GU) < I_DN) { (T_).W = A.in[I_D1] + (size_t)l * D * FF; (T_).WT = (bf16*)(wl + WO_D1); (T_).N = D; (T_).K = FF; mode = 0; } \
        else if ((r -= I_DN) < I_IN) { (T_).W = A.in[I_WIN] + (size_t)l * D * DPROJ; (T_).gain = A.in[I_NM] + l * D; (T_).WT = (bf16*)(wl + WO_IN); (T_).N = DPROJ; (T_).K = D; mode = 3; } \
        else if ((r -= I_IN) < I_OUT) { (T_).W = A.in[I_WOUT] + (size_t)l * D * D; (T_).WT = (bf16*)(wl + WO_OUT); (T_).N = D; (T_).K = D; mode = 0; } \
        else if ((r -= I_OUT) < I_GU) { (T_).W = A.in[I_G2] + (size_t)l * D * FF; (T_).gain = A.in[I_N2] + l * D; (T_).WT = (bf16*)(wl + WO_GU2); (T_).N = FF; (T_).K = D; mode = 1; } \
        else if ((r -= I_GU) < I_GU) { (T_).W = A.in[I_U2] + (size_t)l * D * FF; (T_).gain = A.in[I_N2] + l * D; (T_).WT = (bf16*)(wl + WO_GU2); (T_).N = FF; (T_).K = D; mode = 2; } \
        else { r -= I_GU; (T_).W = A.in[I_D2] + (size_t)l * D * FF; (T_).WT = (bf16*)(wl + WO_D2); (T_).N = D; (T_).K = FF; mode = 0; } \
        const int nkb = (T_).K / 64, nb = r / nkb, kb = r % nkb; (T_).k0 = 64 * kb; (T_).n0 = 32 * nb; \
        (T_).dr = mode == 0 ? (T_).n0 : (mode == 3 ? map_in((T_).n0) : map_gu((T_).n0, mode == 2)); } while (0)
    {
        constexpr int NIT = DEPTH * PER_LAYER; int it = gw; float vA[32], vB[32]; TItem tA, tB;
        if (it < NIT) { P0_DECODE(it, tA); p0_item_load(tA, lane, vA); }
        while (it < NIT) {
            const int it1 = it + NGW; const bool h1 = it1 < NIT;
            if (h1) { P0_DECODE(it1, tB); p0_item_load(tB, lane, vB); }
            p0_item_finish(tA, scr, lane, vA);
            const int it2 = it1 + NGW; const bool h2 = it2 < NIT;
            if (h2) { P0_DECODE(it2, tA); p0_item_load(tA, lane, vA); }
            if (h1) p0_item_finish(tB, scr, lane, vB);
            it = it2;
        }
    }
#undef P0_DECODE
    const int gt = blockIdx.x * (NWAVES * 64) + F.tid, NGT = F.G * NWAVES * 64;
    for (int i = gt; i < DEPTH * 128 * D / 8; i += NGT) { const int l = i / (128 * D / 8), r = i % (128 * D / 8);
        *(GAS v4u*)(ws + WS_W + (size_t)l * W_LAYER + WO_IN + (size_t)DPROJ * D * 2 + (size_t)r * 16) = (v4u){0u, 0u, 0u, 0u}; }
    for (int r = gw; r < DEPTH * 4 * 128; r += NGW) { const int l = r >> 9, rr = r & 511, t = rr & 127; float sum = 0.f;
        GAS bf16* wm = (GAS bf16*)(ws + WS_W + (size_t)l * W_LAYER + WO_S) + (size_t)rr * 128;
#pragma unroll
        for (int i = 0; i < 2; ++i) { const int sidx = lane + 64 * i; const unsigned mb = sidx <= t ? f2bf(A.in[I_WS][(size_t)r * 128 + sidx]) : 0u; wm[sidx] = (bf16)mb; sum += __uint_as_float(mb << 16); }
        sum = wave_sum(sum);
        if (lane == 0) ((GAS float*)(ws + WS_W + (size_t)l * W_LAYER + WO_RSW))[rr] = sum; }
    GAS float* rowss = (GAS float*)(ws + WS_ROWSS);
    for (int i = gt; i < 6 * M; i += NGT) rowss[M + i] = 0.f;
    const float* x = A.in[I_X]; GAS bf16* xb = (GAS bf16*)(ws + WS_XB);
    for (int xrep = 0; xrep <= PROBE_X; ++xrep)
    for (int m0 = gw * 4; m0 < M; m0 += NGW * 4) {
        f32x4 v[4][4]; float sq[4];
#pragma unroll
        for (int r = 0; r < 4; ++r) { const GAS f32x4* xr = (const GAS f32x4*)(x + (size_t)(m0 + r) * D) + lane;
#pragma unroll
            for (int j = 0; j < 4; ++j) v[r][j] = xr[64 * j]; }
#pragma unroll
        for (int r = 0; r < 4; ++r) { float s = 0.f;
#pragma unroll
            for (int j = 0; j < 4; ++j) s += (v[r][j].x * v[r][j].x + v[r][j].y * v[r][j].y) + (v[r][j].z * v[r][j].z + v[r][j].w * v[r][j].w);
            sq[r] = s; }
#pragma unroll
        for (int o = 1; o < 64; o <<= 1) {
#pragma unroll
            for (int r = 0; r < 4; ++r) sq[r] += __shfl_xor(sq[r], o); }
#pragma unroll
        for (int r = 0; r < 4; ++r) { GAS v2u* o8 = (GAS v2u*)(xb + (size_t)(m0 + r) * D) + lane;
#pragma unroll
            for (int j = 0; j < 4; ++j) o8[64 * j] = (v2u){pk2(v[r][j].x, v[r][j].y), pk2(v[r][j].z, v[r][j].w)}; }
        if (lane < 4) rowss[m0 + lane] = lane == 0 ? sq[0] : (lane == 1 ? sq[1] : (lane == 2 ? sq[2] : sq[3]));
    }
}

__device__ __forceinline__ void final_phase(Frame& F, const Args& A) {
    unsigned char* ws = A.ws; LAUNDER_S(ws);
    const int gw = blockIdx.x * NWAVES + F.wave, NGW = F.G * NWAVES, lane = F.lane;
    const GAS float* rowss = (const GAS float*)(ws + WS_ROWSS) + 6 * (size_t)M; const float* g = A.in[I_NF]; const GAS bf16* xb = (const GAS bf16*)(ws + WS_XB);
    f32x4 gv[4];
#pragma unroll
    for (int j = 0; j < 4; ++j) gv[j] = *((const f32x4*)g + lane + 64 * j);
    for (int m0 = gw * 4; m0 < M; m0 += NGW * 4) {
        v2u xv[4][4]; float rs[4];
#pragma unroll
        for (int r = 0; r < 4; ++r) { rs[r] = rowss[m0 + r]; const GAS v2u* xr = (const GAS v2u*)(xb + (size_t)(m0 + r) * D) + lane;
#pragma unroll
            for (int j = 0; j < 4; ++j) xv[r][j] = xr[64 * j]; }
#pragma unroll
        for (int r = 0; r < 4; ++r) { const float sc = __builtin_amdgcn_rsqf(rs[r] * (1.0f / 1024.0f) + RMS_EPS); GAS f32x4* orow = (GAS f32x4*)(A.out + (size_t)(m0 + r) * D) + lane;
#pragma unroll
            for (int j = 0; j < 4; ++j) { const f32x4 v = (f32x4){bflo(xv[r][j].x), bfhi(xv[r][j].x), bflo(xv[r][j].y), bfhi(xv[r][j].y)}; orow[64 * j] = v * sc * gv[j]; } }
    }
}

constexpr int TA_ROW = 784;
constexpr int ST_OFF = 158 * TA_ROW;
constexpr int HOLD_OFF = RING_BYTES + 2048;
constexpr int VT_STR = 132;
static_assert(ST_OFF + 1024 <= RING_BYTES && 256 * VT_STR * 2 <= RING_BYTES && HOLD_OFF + 32 * TA_ROW <= LDS_BYTES, "mixer LDS");
typedef float f32x2 __attribute__((ext_vector_type(2)));
__device__ __forceinline__ float quad_sum(float v) {
    v += __builtin_bit_cast(float, __builtin_amdgcn_update_dpp(0, __builtin_bit_cast(int, v), 0xB1, 0xF, 0xF, true));
    v += __builtin_bit_cast(float, __builtin_amdgcn_update_dpp(0, __builtin_bit_cast(int, v), 0x4E, 0xF, 0xF, true));
    return v;
}
__device__ __forceinline__ void mixer_c_item(const GAS bf16* P, GAS bf16* MX, const float* ccw, int tok0, int pos0, int it) {
    const int t = it / 48, c8 = it % 48; const int pos = pos0 + t;
    const GAS bf16* base = P + (size_t)(tok0 + t) * PACT_W;
    const v4u x0 = *(const GAS v4u*)(base + P_CX + c8 * 8); v4u x1 = (v4u){0u, 0u, 0u, 0u}, x2 = x1;
    if (pos >= 1) x1 = *(const GAS v4u*)(base - PACT_W + P_CX + c8 * 8);
    if (pos >= 2) x2 = *(const GAS v4u*)(base - 2 * PACT_W + P_CX + c8 * 8);
    const v4u cb = *(const GAS v4u*)(base + P_CB + c8 * 8);
    const f32x4 w0a = *(const f32x4*)(ccw + 0 * DC + c8 * 8), w0b = *(const f32x4*)(ccw + 0 * DC + c8 * 8 + 4);
    const f32x4 w1a = *(const f32x4*)(ccw + 1 * DC + c8 * 8), w1b = *(const f32x4*)(ccw + 1 * DC + c8 * 8 + 4);
    const f32x4 w2a = *(const f32x4*)(ccw + 2 * DC + c8 * 8), w2b = *(const f32x4*)(ccw + 2 * DC + c8 * 8 + 4);
    v4u o;
#pragma unroll
    for (int e = 0; e < 4; ++e) {
        const float wl0 = e < 2 ? w0a[2 * e] : w0b[2 * e - 4], wh0 = e < 2 ? w0a[2 * e + 1] : w0b[2 * e - 3];
        const float wl1 = e < 2 ? w1a[2 * e] : w1b[2 * e - 4], wh1 = e < 2 ? w1a[2 * e + 1] : w1b[2 * e - 3];
        const float wl2 = e < 2 ? w2a[2 * e] : w2b[2 * e - 4], wh2 = e < 2 ? w2a[2 * e + 1] : w2b[2 * e - 3];
        const float lo_ = bflo(cb[e]) * (wl0 * bflo(x2[e]) + wl1 * bflo(x1[e]) + wl2 * bflo(x0[e]));
        const float hi_ = bfhi(cb[e]) * (wh0 * bfhi(x2[e]) + wh1 * bfhi(x1[e]) + wh2 * bfhi(x0[e]));
        o[e] = pk2(lo_, hi_); }
    *(GAS v4u*)(MX + (size_t)(tok0 + t) * D + MIX_C + c8 * 8) = o;
}
__device__ __forceinline__ void mixer_phase(Frame& F, const Args& A, int l) {
    unsigned char* ws = A.ws; LAUNDER_S(ws);
    int tid_ = threadIdx.x; asm volatile("" : "+v"(tid_)); const int tid = tid_, lane = tid & 63, wave = F.wave;
    const GAS bf16* P = (const GAS bf16*)(ws + WS_PACT); GAS bf16* MX = (GAS bf16*)(ws + WS_MIX);
    const float* caw = A.in[I_CAW] + l * 31 * DA; const float* cab = A.in[I_CAB] + l * DA;
    const float* lag = A.in[I_LAG] + l * DA; const float* lab = A.in[I_LAB] + l * DA;
    const float* lvg = A.in[I_LVG] + l * DB; const float* lvb = A.in[I_LVB] + l * DB;
    const float* bs = A.in[I_BS] + l * 4 * CHUNK; const float* ccw = A.in[I_CCW] + l * 3 * DC;
    const GAS bf16* Wm = (const GAS bf16*)(ws + WS_W + (size_t)l * W_LAYER + WO_S);
    const GAS float* RSW = (const GAS float*)(ws + WS_W + (size_t)l * W_LAYER + WO_RSW);
    LAS unsigned char* T = F.lds + RING_OFF;
    LAS f32x2* ST = (LAS f32x2*)(T + ST_OFF);
    for (int q = blockIdx.x; q < NCHUNK; q += F.G) {
        const int tok0 = q * CHUNK; const int pos0 = (q & 15) * CHUNK;
        for (int p = tid; p < 158 * 48; p += NWAVES * 64) { const int j = p / 48, c8 = p % 48; v4u v = (v4u){0u, 0u, 0u, 0u};
            if (pos0 + j >= 30) v = *(const GAS v4u*)(P + (size_t)(tok0 - 30 + j) * PACT_W + P_GLU + c8 * 8);
            *(LAS v4u*)(T + j * TA_ROW + c8 * 16) = v; }
        __syncthreads();
        if (wave < 6) {
            const int half = wave >= 3 ? 1 : 0, p = tid - half * 192; f32x2 w2[31];
#pragma unroll
            for (int k = 0; k < 31; ++k) w2[k] = *(const f32x2*)(caw + k * DA + 2 * p);
            const f32x2 bias2 = *(const f32x2*)(cab + 2 * p);
            LAS unsigned char* colp = T + 4 * p;
#define CONV_LOOP(NB, RD, WR) do { LAS unsigned char* rd_ = (RD); LAS unsigned char* wr_ = (WR); \
                _Pragma("unroll 1") for (int tb = 0; tb < (NB); ++tb, rd_ += 4 * TA_ROW, wr_ += 4 * TA_ROW) { f32x2 in2[34]; \
                    _Pragma("unroll") for (int i = 0; i < 34; ++i) { const unsigned wd = *(const LAS unsigned*)(rd_ + i * TA_ROW); in2[i] = (f32x2){bflo(wd), bfhi(wd)}; } \
                    _Pragma("unroll") for (int i = 0; i < 4; ++i) { f32x2 o = bias2; _Pragma("unroll") for (int k = 0; k < 31; ++k) o = w2[k] * in2[i + k] + o; *(LAS unsigned*)(wr_ + i * TA_ROW) = pk2(o.x, o.y); } } } while (0)
            if (half == 0) { CONV_LOOP(16, colp, colp); }
            else { CONV_LOOP(8, colp + 64 * TA_ROW, F.lds + HOLD_OFF + 4 * p); CONV_LOOP(8, colp + 96 * TA_ROW, colp + 96 * TA_ROW); }
#undef CONV_LOOP
        }
        for (int v = (wave >= 6 ? 0 : 32); v < 36; ++v) { const int it = v < 32 ? (tid - 6 * 64) + 128 * v : 4096 + tid + NWAVES * 64 * (v - 32);
            mixer_c_item(P, MX, ccw, tok0, pos0, it); }
        __syncthreads();
        {
            const int t = tid >> 2, qq = tid & 3; const LAS unsigned char* rp = ((t >= 64 && t < 96) ? (F.lds + HOLD_OFF + (t - 64) * TA_ROW) : (T + t * TA_ROW)) + qq * 192; float s = 0.f, s2 = 0.f;
#pragma unroll
            for (int j = 0; j < 12; ++j) { const v4u d = *(const LAS v4u*)(rp + 16 * j);
#pragma unroll
                for (int e = 0; e < 4; ++e) { const float lo = bflo(d[e]), hi = bfhi(d[e]); s += lo + hi; s2 += lo * lo + hi * hi; } }
            s = quad_sum(s); s2 = quad_sum(s2);
            const float mean = s * (1.0f / DA), var = s2 * (1.0f / DA) - mean * mean;
            if (qq == 0) ST[t] = (f32x2){mean, __builtin_amdgcn_rsqf(fmaxf(var, 0.f) + LN_EPS)};
        }
        __syncthreads();
        {
            float g6[6], b6[6];
#pragma unroll
            for (int j = 0; j < 3; ++j) { const f32x2 gg = *(const f32x2*)(lag + 2 * lane + 128 * j), bb = *(const f32x2*)(lab + 2 * lane + 128 * j); g6[2 * j] = gg.x; g6[2 * j + 1] = gg.y; b6[2 * j] = bb.x; b6[2 * j + 1] = bb.y; }
#pragma unroll 4
            for (int tt = 0; tt < 16; ++tt) { const int t = wave * 16 + tt; const f32x2 st = ST[t]; const LAS unsigned char* rowp = (t >= 64 && t < 96) ? (F.lds + HOLD_OFF + (t - 64) * TA_ROW) : (T + t * TA_ROW);
#pragma unroll
                for (int j = 0; j < 3; ++j) { const unsigned wd = *(const LAS unsigned*)(rowp + 4 * lane + 256 * j);
                    const float y0 = (bflo(wd) - st.x) * st.y * g6[2 * j] + b6[2 * j], y1 = (bfhi(wd) - st.x) * st.y * g6[2 * j + 1] + b6[2 * j + 1];
                    *(GAS unsigned*)(MX + (size_t)(tok0 + t) * D + MIX_A + 2 * lane + 128 * j) = pk2(y0 * sigm(y0), y1 * sigm(y1)); }
            }
        }
        v4u xv[8];
        {   const int t = tid >> 2, qq = tid & 3; const GAS bf16* vr = P + (size_t)(tok0 + t) * PACT_W + P_GV + qq * 64;
#pragma unroll
            for (int j = 0; j < 8; ++j) xv[j] = *(const GAS v4u*)(vr + 8 * j); }
        __syncthreads();
        {
            const int t = tid >> 2, qq = tid & 3; float s = 0.f, s2 = 0.f;
#pragma unroll
            for (int j = 0; j < 8; ++j)
#pragma unroll
                for (int e = 0; e < 4; ++e) { const float lo = bflo(xv[j][e]), hi = bfhi(xv[j][e]); s += lo + hi; s2 += lo * lo + hi * hi; }
            s = quad_sum(s); s2 = quad_sum(s2);
            const float mean = s * (1.0f / DB), rstd = __builtin_amdgcn_rsqf(fmaxf(s2 * (1.0f / DB) - mean * mean, 0.f) + LN_EPS);
            LAS unsigned short* Vt = (LAS unsigned short*)T + (qq * 64) * VT_STR + t;
#pragma unroll
            for (int j = 0; j < 8; ++j)
#pragma unroll
                for (int e = 0; e < 4; ++e) { Vt[(8 * j + 2 * e) * VT_STR] = (unsigned short)f2bf((bflo(xv[j][e]) - mean) * rstd); Vt[(8 * j + 2 * e + 1) * VT_STR] = (unsigned short)f2bf((bfhi(xv[j][e]) - mean) * rstd); }
        }
        const int fr = lane & 15, fq = lane >> 4, trow = 16 * wave + fr, nks = (16 * wave + 15) / 32 + 1;
        bf16x8 wf[4][4];
#pragma unroll
        for (int h = 0; h < 4; ++h)
#pragma unroll
            for (int ks = 0; ks < 4; ++ks) { wf[h][ks] = (bf16x8){0, 0, 0, 0, 0, 0, 0, 0}; if (ks < nks) wf[h][ks] = *(const GAS bf16x8*)(Wm + ((size_t)(h * CHUNK + trow) * CHUNK + 32 * ks + 8 * fq)); }
        __syncthreads();
        {
            const LAS unsigned short* Vt = (const LAS unsigned short*)T;
            const size_t tok = (size_t)(tok0 + trow);
#pragma unroll
            for (int h = 0; h < 4; ++h) {
                f32x4 acc[4];
#pragma unroll
                for (int nt = 0; nt < 4; ++nt) acc[nt] = (f32x4){0.f, 0.f, 0.f, 0.f};
#pragma unroll
                for (int ks = 0; ks < 4; ++ks) if (ks < nks) {
#pragma unroll
                    for (int nt = 0; nt < 4; ++nt) { const LAS unsigned short* vp = Vt + (h * 64 + nt * 16 + fr) * VT_STR + 32 * ks + 8 * fq;
                        const s16x4 v0 = *(const LAS s16x4*)vp, v1 = *(const LAS s16x4*)(vp + 4);
                        const bf16x8 vf = __builtin_shufflevector(v0, v1, 0, 1, 2, 3, 4, 5, 6, 7);
                        acc[nt] = __builtin_amdgcn_mfma_f32_16x16x32_bf16(vf, wf[h][ks], acc[nt], 0, 0, 0); }
                }
                const float bsv = bs[h * CHUNK + trow], rsw = RSW[h * CHUNK + trow];
#pragma unroll
                for (int nt = 0; nt < 4; ++nt) { const int d0 = h * 64 + nt * 16 + 4 * fq;
                    const v2u gu = *(const GAS v2u*)(P + tok * PACT_W + P_GU + d0);
                    const f32x4 gg = *(const f32x4*)(lvg + d0), bb = *(const f32x4*)(lvb + d0);
                    const float o0 = bflo(gu.x) * (gg[0] * acc[nt][0] + bb[0] * rsw + bsv), o1 = bfhi(gu.x) * (gg[1] * acc[nt][1] + bb[1] * rsw + bsv);
                    const float o2 = bflo(gu.y) * (gg[2] * acc[nt][2] + bb[2] * rsw + bsv), o3 = bfhi(gu.y) * (gg[3] * acc[nt][3] + bb[3] * rsw + bsv);
                    *(GAS v2u*)(MX + tok * D + MIX_B + d0) = (v2u){pk2(o0, o1), pk2(o2, o3)}; }
            }
        }
        __syncthreads();
    }
}

__global__ void __launch_bounds__(NWAVES * 64, 2) hybrid_fwd(Args args) {
    extern __shared__ __attribute__((aligned(16))) unsigned char lds[];
    if (args.ph_hi > N_PHASES) cg::this_grid().sync();
    Frame F;
    F.lds = (LAS unsigned char*)lds;
    F.MISC = (volatile LAS unsigned*)(F.lds + MISC_OFF);
    F.tid = threadIdx.x; F.lane = F.tid & 63; F.wave = __builtin_amdgcn_readfirstlane(F.tid >> 6);
    F.G = gridDim.x;
    F.ctl = (gu32*)(args.ws + WS_CTL);
    for (int u = F.tid; u < (LDS_BYTES - LDSCTL_OFF) / 4; u += NWAVES * 64) ((LAS unsigned*)(F.lds + LDSCTL_OFF))[u] = 0u;
    __syncthreads();
    const int lo = args.ph_lo, hi = args.ph_hi;
    const bool multi = (hi - lo) > 1;
    XcdBarrier bar; bar.bar = (unsigned*)(F.ctl + CW_BAR); bar.x = 0; bar.st = nullptr;
    if (multi && !MK_CG_SYNC) bar = xcd_barrier_post((unsigned*)(F.ctl + CW_BAR), F.MISC + 8);
#define IN(k) (lo <= (k) && (k) < hi)
#define BOTH(k) (IN(k) && IN((k) + 1))
#define SEAM(k) do { if (BOTH(k)) { if (MK_CG_SYNC) cg::this_grid().sync(); else xcd_barrier(bar); } } while (0)
#define PHASE_PTRS() unsigned char* ws = args.ws; LAUNDER_S(ws); float* rowss = (float*)(ws + WS_ROWSS); unsigned char* wl = ws + WS_W + (size_t)l * W_LAYER; (void)rowss; (void)wl

    if (IN(0)) { for (int rep = 0; rep <= PROBE_PRO; ++rep) p0_prologue(F, args); SEAM(0); }
#pragma unroll 1
    for (int l = 0; l < DEPTH; ++l) {
        const int pb = 1 + 7 * l;
        if (IN(pb + 0)) {
            PHASE_PTRS();
            pg8::Gemm g{(const bf16*)(ws + WS_XB), (const bf16*)(wl + WO_GU1), M, NGU, D}; pg8::StaticOrder S; S.init(M, NGU, F.G, (int)blockIdx.x);
            pg8::EpiSwiGLU E{(bf16*)(ws + WS_HID), rowss + (size_t)(3 * l) * M, FF, (LAS float*)(F.lds + RSTBL_OFF)};
            for (int rep = 0; rep <= PROBE_GU; ++rep) { pg8::gemm_phase<pg8::EpiSwiGLU, pg8::StaticOrder, PG8_ALIGN, PG8_SP2>(F.lds + RING_OFF, g, S, E); }
            for (int rep = 0; rep < PROBE_NULLGU; ++rep) { pg8::EpiNull EN; pg8::gemm_phase<pg8::EpiNull, pg8::StaticOrder, PG8_ALIGN, PG8_SP2>(F.lds + RING_OFF, g, S, EN); }
            SEAM(pb + 0);
        }
        if (IN(pb + 1)) {
            PHASE_PTRS();
            pg8::Gemm g{(const bf16*)(ws + WS_HID), (const bf16*)(wl + WO_D1), M, D, FF}; pg8::StaticOrder S; S.init(M, D, F.G, (int)blockIdx.x);
            pg8::EpiResid E{(bf16*)(ws + WS_XB), rowss + (size_t)(3 * l + 1) * M, 0.5f, 1};
            for (int rep = PROBE_D; rep >= 0; --rep) { E.live = (rep == 0); pg8::gemm_phase<pg8::EpiResid, pg8::StaticOrder, PG8_ALIGN, PG8_SP2>(F.lds + RING_OFF, g, S, E); }
            SEAM(pb + 1);
        }
        if (IN(pb + 2)) {
            PHASE_PTRS();
            pg8::Gemm g{(const bf16*)(ws + WS_XB), (const bf16*)(wl + WO_IN), M, NIN, D}; pg8::StaticOrder S; S.init(M, NIN, F.G, (int)blockIdx.x);
            pg8::EpiIn E{(bf16*)(ws + WS_PACT), rowss + (size_t)(3 * l + 1) * M, (LAS float*)(F.lds + RSTBL_OFF)};
            for (int rep = 0; rep <= PROBE_IN; ++rep) { pg8::gemm_phase<pg8::EpiIn, pg8::StaticOrder, PG8_ALIGN, PG8_SP2>(F.lds + RING_OFF, g, S, E); }
            SEAM(pb + 2);
        }
        if (IN(pb + 3)) { for (int rep = 0; rep <= PROBE_MIX; ++rep) mixer_phase(F, args, l); SEAM(pb + 3); }
        if (IN(pb + 4)) {
            PHASE_PTRS();
            pg8::Gemm g{(const bf16*)(ws + WS_MIX), (const bf16*)(wl + WO_OUT), M, D, D}; pg8::StaticOrder S; S.init(M, D, F.G, (int)blockIdx.x);
            pg8::EpiResid E{(bf16*)(ws + WS_XB), rowss + (size_t)(3 * l + 2) * M, 1.0f, 1};
            for (int rep = PROBE_OUT; rep >= 0; --rep) { E.live = (rep == 0); pg8::gemm_phase<pg8::EpiResid, pg8::StaticOrder, PG8_ALIGN, PG8_SP2>(F.lds + RING_OFF, g, S, E); }
            SEAM(pb + 4);
        }
        if (IN(pb + 5)) {
            PHASE_PTRS();
            pg8::Gemm g{(const bf16*)(ws + WS_XB), (const bf16*)(wl + WO_GU2), M, NGU, D}; pg8::StaticOrder S; S.init(M, NGU, F.G, (int)blockIdx.x);
            pg8::EpiSwiGLU E{(bf16*)(ws + WS_HID), rowss + (size_t)(3 * l + 2) * M, FF, (LAS float*)(F.lds + RSTBL_OFF)};
            for (int rep = 0; rep <= PROBE_GU; ++rep) { pg8::gemm_phase<pg8::EpiSwiGLU, pg8::StaticOrder, PG8_ALIGN, PG8_SP2>(F.lds + RING_OFF, g, S, E); }
            SEAM(pb + 5);
        }
        if (IN(pb + 6)) {
            PHASE_PTRS();
            pg8::Gemm g{(const bf16*)(ws + WS_HID), (const bf16*)(wl + WO_D2), M, D, FF}; pg8::StaticOrder S; S.init(M, D, F.G, (int)blockIdx.x);
            pg8::EpiResid E{(bf16*)(ws + WS_XB), rowss + (size_t)(3 * l + 3) * M, 0.5f, 1};
            for (int rep = PROBE_D; rep >= 0; --rep) { E.live = (rep == 0); pg8::gemm_phase<pg8::EpiResid, pg8::StaticOrder, PG8_ALIGN, PG8_SP2>(F.lds + RING_OFF, g, S, E); }
            SEAM(pb + 6);
        }
    }
    if (IN(15)) { for (int rep = 0; rep <= PROBE_FIN; ++rep) final_phase(F, args); }
#undef IN
#undef BOTH
#undef SEAM
#undef PHASE_PTRS
}

extern "C" void kernel_launch(void* const* d_in, const int* in_sizes, int n_in, void* d_out, int out_size, void* d_ws, size_t ws_size, hipStream_t stream) {
    static int grid = 0;
    if (grid == 0) {
        if (n_in != 22 || in_sizes[0] != M * D || out_size != M * D || ws_size < WS_END) { fprintf(stderr, "kernel_launch: shape/workspace mismatch (n_in %d in0 %d out %d ws %zu)\n", n_in, n_in > 0 ? in_sizes[0] : -1, out_size, ws_size); grid = -1; return; }
        int dev = 0, cus = 0, per_cu = 0;
        if (hipGetDevice(&dev) != hipSuccess || hipDeviceGetAttribute(&cus, hipDeviceAttributeMultiprocessorCount, dev) != hipSuccess) { grid = -1; return; }
        if (hipFuncSetAttribute((const void*)hybrid_fwd, hipFuncAttributeMaxDynamicSharedMemorySize, LDS_BYTES) != hipSuccess) { fprintf(stderr, "kernel_launch: hipFuncSetAttribute failed\n"); grid = -1; return; }
        if (hipOccupancyMaxActiveBlocksPerMultiprocessor(&per_cu, (const void*)hybrid_fwd, NWAVES * 64, LDS_BYTES) != hipSuccess || per_cu < 1) { fprintf(stderr, "kernel_launch: occupancy query says %d blocks per CU\n", per_cu); per_cu = 1; }
        (void)hipGetLastError();
        grid = cus * 1;
    }
    if (grid < 0) return;
    (void)hipMemsetAsync((char*)d_ws + WS_CTL, 0, CTL_ZERO_BYTES, stream);
    Args a{};
    for (int i = 0; i < 22; ++i) a.in[i] = (const float*)d_in[i];
    a.out = (float*)d_out; a.ws = (unsigned char*)d_ws;
#if MK_N_LAUNCHES == 1
    a.ph_lo = 0; a.ph_hi = N_PHASES;
    void* kargs[] = {&a};
    hipError_t e = hipLaunchCooperativeKernel((const void*)hybrid_fwd, dim3(grid), dim3(NWAVES * 64), kargs, LDS_BYTES, stream);
    if (e != hipSuccess) fprintf(stderr, "kernel_launch: cooperative launch failed: %s (grid %d)\n", hipGetErrorString(e), grid);
#else
    for (int p = 0; p < N_PHASES; ++p) { a.ph_lo = p; a.ph_hi = p + 1;
        hipLaunchKernelGGL(hybrid_fwd, dim3(grid), dim3(NWAVES * 64), LDS_BYTES, stream, a); }
#endif
}
```

```cpp
#include <hip/hip_runtime.h>
#include <hip/hip_cooperative_groups.h>
#include <cstdio>
#include <cstdint>
namespace cg = cooperative_groups;

#ifndef MK_N_LAUNCHES
#define MK_N_LAUNCHES 1
#endif
#ifndef MK_CG_SYNC
#define MK_CG_SYNC 0
#endif

#ifndef PROBE_GU
#define PROBE_GU 0
#endif
#ifndef PROBE_NULLGU
#define PROBE_NULLGU 0
#endif
#ifndef PROBE_FIXGU
#define PROBE_FIXGU 0
#endif
#ifndef PROBE_D
#define PROBE_D 0
#endif
#ifndef PROBE_IN
#define PROBE_IN 0
#endif
#ifndef PROBE_OUT
#define PROBE_OUT 0
#endif
#ifndef PROBE_MIX
#define PROBE_MIX 0
#endif
#ifndef PROBE_PRO
#define PROBE_PRO 0
#endif
#ifndef PROBE_FIN
#define PROBE_FIN 0
#endif

constexpr int NWAVES = 8;
constexpr int BATCH = 16, SEQ = 2048, M = BATCH * SEQ, D = 1024, FF = 2816, NGU = 2 * FF, DPROJ = 2432, NIN = 2560, DEPTH = 2;
constexpr int DA = 384, DB = 256, DC = 384, PACT_W = 1664, CHUNK = 128, NCHUNK = M / CHUNK;
constexpr int P_GLU = 0, P_GU = 384, P_GV = 640, P_CX = 896, P_CB = 1280;
constexpr int MIX_A = 0, MIX_B = 384, MIX_C = 640;
constexpr float RMS_EPS = 1e-6f, LN_EPS = 1e-5f;
constexpr int N_PHASES = 16;

namespace pg8 {
#define PG8_LAS __attribute__((address_space(3)))
typedef unsigned short bf16_t;
typedef short bf16x8 __attribute__((ext_vector_type(8)));
typedef float f32x4 __attribute__((ext_vector_type(4)));
typedef unsigned u32x4 __attribute__((ext_vector_type(4)));
constexpr int BM = 256, BK = 64, HALF = 128, HTB = HALF * BK * 2  , STAGE_BYTES = 8 * HTB, NXCD = 8, WGM = 8;

__host__ __device__ __forceinline__ int lds_byte(int r, int c) { const int st = (r >> 4) * 2 + (c >> 5), rr = r & 15, cc = c & 31, ob = rr * 64 + cc * 2; return st * 1024 + (ob ^ (((ob >> 9) & 1) << 5)); }
__host__ __device__ __forceinline__ void stage_rc(int b, int& R, int& C) { const int st = b / 1024, sb = b % 1024, swz = sb ^ (((sb >> 9) & 1) << 5); R = (st >> 1) * 16 + swz / 64; C = (st & 1) * 32 + (swz % 64) / 2; }
__host__ __device__ __forceinline__ int perm32(int rho) { const int n = rho >> 4, i = rho & 15; return 8 * (i >> 2) + 4 * n + (i & 3); }

struct Unit { int pm, pn; };
struct Gemm { const bf16_t* A; const bf16_t* Bt; int M, N, K; };

struct StaticOrder {
    int nM, nN, nwg, G, c;
    __host__ __device__ void init(int M, int N, int G_, int c_) { nM = M / BM; nN = N / BM; nwg = nM * nN; G = G_; c = c_; }
    __host__ __device__ bool next(int i, Unit& u) const {
        const long L = (long)i * G + c; if (L >= nwg) return false;
        int wgid = (int)L; { const int q = nwg / NXCD, r = nwg % NXCD, xcd = wgid % NXCD, off = wgid / NXCD; wgid = (xcd < r ? xcd * (q + 1) : r * (q + 1) + (xcd - r) * q) + off; }
        const int nig = WGM * nN, gid = wgid / nig, fm = gid * WGM, gsz = (nM - fm) < WGM ? (nM - fm) : WGM;
        u.pm = fm + ((wgid % nig) % gsz); u.pn = (wgid % nig) / gsz; return true;
    }
    __device__ __forceinline__ void a_ready(const Unit&) const {}
    __device__ __forceinline__ void done(const Unit&) const {}
};

__device__ __forceinline__ unsigned cvt_pk_bf16(float lo, float hi) { unsigned r; asm volatile("v_cvt_pk_bf16_f32 %0, %1, %2" : "=v"(r) : "v"(lo), "v"(hi)); return r; }
__device__ __forceinline__ float sigmoid_f(float x) { return __builtin_amdgcn_rcpf(1.0f + __builtin_amdgcn_exp2f(-1.4426950408889634f * x)); }
__device__ __forceinline__ float gelu_tanh_f(float x) { const float z = x * (1.5957691216057308f + 0.07135481282817f * x * x); return x * sigmoid_f(z); }
__device__ __forceinline__ u32x4 pack8(const f32x4 a, const f32x4 b) { u32x4 w; w.x = cvt_pk_bf16(a[0], a[1]); w.y = cvt_pk_bf16(a[2], a[3]); w.z = cvt_pk_bf16(b[0], b[1]); w.w = cvt_pk_bf16(b[2], b[3]); return w; }
#define PG8_GAS __attribute__((address_space(1)))
__device__ __forceinline__ f32x4 exp4(const f32x4 t) { f32x4 e; e[0] = __builtin_amdgcn_exp2f(t[0]); e[1] = __builtin_amdgcn_exp2f(t[1]); e[2] = __builtin_amdgcn_exp2f(t[2]); e[3] = __builtin_amdgcn_exp2f(t[3]); return e; }
__device__ __forceinline__ f32x4 rcp4(const f32x4 t) { f32x4 e; e[0] = __builtin_amdgcn_rcpf(t[0]); e[1] = __builtin_amdgcn_rcpf(t[1]); e[2] = __builtin_amdgcn_rcpf(t[2]); e[3] = __builtin_amdgcn_rcpf(t[3]); return e; }
__device__ __forceinline__ f32x4 gelu4(const f32x4 x) { const f32x4 z = x * (x * x * -0.10294324f + -2.3022082f); return x * rcp4(exp4(z) + 1.0f); }
__device__ __forceinline__ float rs_of(float ss) { return __builtin_amdgcn_rsqf(ss * (1.0f / 1024.0f) + 1e-6f); }
__device__ __forceinline__ void load_rs(const float* rowss, int row0, float (&rs)[2][4]) {
    const PG8_GAS float* p = (const PG8_GAS float*)rowss + row0;
#pragma unroll
    for (int ai = 0; ai < 2; ++ai)
#pragma unroll
        for (int m = 0; m < 4; ++m) rs[ai][m] = p[ai * HALF + m * 16];
#pragma unroll
    for (int ai = 0; ai < 2; ++ai)
#pragma unroll
        for (int m = 0; m < 4; ++m) rs[ai][m] = rs_of(rs[ai][m]);
}

__device__ __forceinline__ void dma_rowss(const float* rowss, PG8_LAS float* tbl, int pm, int wid, int lane) {
    if (wid < 4) __builtin_amdgcn_global_load_lds((const unsigned*)(rowss + (size_t)pm * BM + wid * 64 + lane), (PG8_LAS unsigned*)(tbl + wid * 64), 4, 0, 0);
}
__device__ __forceinline__ void load_rs_lds(const PG8_LAS float* tbl, int wr, int fr, float (&rs)[2][4]) {
#pragma unroll
    for (int ai = 0; ai < 2; ++ai)
#pragma unroll
        for (int m = 0; m < 4; ++m) rs[ai][m] = rs_of(tbl[ai * HALF + wr * 64 + m * 16 + fr]);
}
struct EpiSwiGLU {
    static constexpr bool PERM = true, AFTER_DRAIN = false;
    bf16_t* H; const float* rowss; int ldh; PG8_LAS float* tbl;
    __device__ __forceinline__ void prefetch(const Unit& u, int wid, int lane) const { dma_rowss(rowss, tbl, u.pm, wid, lane); }
    __device__ __forceinline__ void operator()(const f32x4 (&acc)[2][2][4][2], const Unit& u, int wr, int wc, int fr, int fq) const {
        const int row0 = u.pm * BM + wr * 64 + fr, col0 = u.pn * HALF + wc * 32 + 8 * fq;
        float rsv[2][4]; load_rs_lds(tbl, wr, fr, rsv);
        PG8_GAS bf16_t* hp = (PG8_GAS bf16_t*)H + (size_t)row0 * ldh + col0;
#pragma unroll
        for (int ai = 0; ai < 2; ++ai)
#pragma unroll
            for (int m = 0; m < 4; ++m) { const float rs = rsv[ai][m], c1 = -1.4426950408889634f * rs, rs2 = rs * rs;
                f32x4 o[2];
#pragma unroll
                for (int n = 0; n < 2; ++n) { const f32x4 g = acc[ai][0][m][n], t = g * c1; f32x4 e;
#pragma unroll
                    for (int j = 0; j < 4; ++j) e[j] = __builtin_amdgcn_exp2f(t[j]);
                    const f32x4 den = e + 1.0f; f32x4 r;
#pragma unroll
                    for (int j = 0; j < 4; ++j) r[j] = __builtin_amdgcn_rcpf(den[j]);
                    o[n] = (g * acc[ai][1][m][n]) * (r * rs2); }
                *(PG8_GAS u32x4*)(hp + (size_t)(ai * HALF + m * 16) * ldh) = pack8(o[0], o[1]); }
    }
};
__device__ __forceinline__ float bf_lo(unsigned w) { return __uint_as_float(w << 16); }
__device__ __forceinline__ float bf_hi(unsigned w) { return __uint_as_float(w & 0xffff0000u); }
struct EpiResid {
    static constexpr bool PERM = true, AFTER_DRAIN = false;
    bf16_t* xb; float* rowss; float scale; int live;
    __device__ __forceinline__ void prefetch(const Unit&, int, int) const {}
    __device__ __forceinline__ void operator()(const f32x4 (&acc)[2][2][4][2], const Unit& u, int wr, int wc, int fr, int fq) const {
        const int row0 = u.pm * BM + wr * 64 + fr, col0 = u.pn * BM + wc * 32 + 8 * fq;
        PG8_GAS bf16_t* xp = (PG8_GAS bf16_t*)xb + (size_t)row0 * 1024 + col0; PG8_GAS float* sp = (PG8_GAS float*)rowss + row0;
#pragma unroll
        for (int ai = 0; ai < 2; ++ai) {
            u32x4 x[4][2];
#pragma unroll
            for (int m = 0; m < 4; ++m)
#pragma unroll
                for (int bj = 0; bj < 2; ++bj) x[m][bj] = *(const PG8_GAS u32x4*)(xp + (size_t)(ai * HALF + m * 16) * 1024 + bj * HALF);
#pragma unroll
            for (int m = 0; m < 4; ++m) { float ss = 0.f;
#pragma unroll
                for (int bj = 0; bj < 2; ++bj) { const float sc = live ? scale : 0.f; const f32x4 a0 = acc[ai][bj][m][0] * sc, a1 = acc[ai][bj][m][1] * sc; const u32x4 xv = x[m][bj]; f32x4 v0, v1;
                    v0[0] = bf_lo(xv[0]) + a0[0]; v0[1] = bf_hi(xv[0]) + a0[1]; v0[2] = bf_lo(xv[1]) + a0[2]; v0[3] = bf_hi(xv[1]) + a0[3];
                    v1[0] = bf_lo(xv[2]) + a1[0]; v1[1] = bf_hi(xv[2]) + a1[1]; v1[2] = bf_lo(xv[3]) + a1[2]; v1[3] = bf_hi(xv[3]) + a1[3];
                    *(PG8_GAS u32x4*)(xp + (size_t)(ai * HALF + m * 16) * 1024 + bj * HALF) = pack8(v0, v1);
                    ss += (v0[0] * v0[0] + v0[1] * v0[1]) + (v0[2] * v0[2] + v0[3] * v0[3]) + (v1[0] * v1[0] + v1[1] * v1[1]) + (v1[2] * v1[2] + v1[3] * v1[3]); }
                ss += __shfl_xor(ss, 16); ss += __shfl_xor(ss, 32);
                if (fq == 0 && live) (void)__builtin_amdgcn_global_atomic_fadd_f32(sp + ai * HALF + m * 16, ss); }
        }
    }
};
struct EpiIn {
    static constexpr bool PERM = true, AFTER_DRAIN = false;
    bf16_t* P; const float* rowss; PG8_LAS float* tbl;
    __device__ __forceinline__ void prefetch(const Unit& u, int wid, int lane) const { dma_rowss(rowss, tbl, u.pm, wid, lane); }
    __device__ __forceinline__ void operator()(const f32x4 (&acc)[2][2][4][2], const Unit& u, int wr, int wc, int fr, int fq) const {
        const int row0 = u.pm * BM + wr * 64 + fr, cw = wc * 32 + 8 * fq, pn = u.pn;
        float rsv[2][4]; load_rs_lds(tbl, wr, fr, rsv);
        PG8_GAS bf16_t* pp = (PG8_GAS bf16_t*)P + (size_t)row0 * 1664 + cw;
#pragma unroll
        for (int ai = 0; ai < 2; ++ai)
#pragma unroll
            for (int m = 0; m < 4; ++m) { const float rs = rsv[ai][m];
                PG8_GAS bf16_t* rp = pp + (size_t)(ai * HALF + m * 16) * 1664;
                const f32x4 A0 = acc[ai][0][m][0], A1 = acc[ai][0][m][1], B0 = acc[ai][1][m][0], B1 = acc[ai][1][m][1];
                if (pn < 3) { const float c1 = -1.4426950408889634f * rs;
                    *(PG8_GAS u32x4*)(rp + 0 + pn * HALF) = pack8(A0 * (rcp4(exp4(B0 * c1) + 1.0f) * rs), A1 * (rcp4(exp4(B1 * c1) + 1.0f) * rs));
                } else if (pn < 5) {
                    *(PG8_GAS u32x4*)(rp + 384 + (pn - 3) * BM) = pack8(gelu4(A0 * rs), gelu4(A1 * rs)); *(PG8_GAS u32x4*)(rp + 384 + (pn - 3) * BM + HALF) = pack8(gelu4(B0 * rs), gelu4(B1 * rs));
                } else if (pn < 8) { const float rs2 = rs * rs;
                    *(PG8_GAS u32x4*)(rp + 896 + (pn - 5) * HALF) = pack8(A0 * B0 * rs2, A1 * B1 * rs2);
                } else if (pn == 8) {
                    *(PG8_GAS u32x4*)(rp + 1280) = pack8(A0 * rs, A1 * rs); *(PG8_GAS u32x4*)(rp + 1280 + HALF) = pack8(B0 * rs, B1 * rs);
                } else {
                    *(PG8_GAS u32x4*)(rp + 1280 + BM) = pack8(A0 * rs, A1 * rs);
                } }
    }
};

struct EpiNull {
    static constexpr bool PERM = true, AFTER_DRAIN = false;
    __device__ __forceinline__ void prefetch(const Unit&, int, int) const {}
    __device__ __forceinline__ void operator()(const f32x4 (&acc)[2][2][4][2], const Unit& u, int wr, int wc, int fr, int fq) const {
#pragma unroll
        for (int ai = 0; ai < 2; ++ai)
#pragma unroll
            for (int bj = 0; bj < 2; ++bj)
#pragma unroll
                for (int m = 0; m < 4; ++m)
#pragma unroll
                    for (int n = 0; n < 2; ++n) asm volatile("" :: "v"(acc[ai][bj][m][n]));
    }
};

template <class Epi, class Sched, bool ALIGN_EPI = false, bool SP2 = false>
__device__ __forceinline__ void gemm_phase(PG8_LAS unsigned char* lds, const Gemm g, const Sched& S, const Epi& E) {
    int tid_ = threadIdx.x; asm volatile("" : "+v"(tid_)); const int tid = tid_, wid = __builtin_amdgcn_readfirstlane(tid >> 6), lane = tid & 63, wr = wid >> 2, wc = wid & 3, fr = lane & 15, fq = lane >> 4;
    const int K = g.K, nt = K / BK;
    unsigned voffA[2], voffB[2];
#pragma unroll
    for (int i = 0; i < 2; ++i) { int R, C; stage_rc(tid * 16 + i * 8192, R, C); const int Rb = Epi::PERM ? ((R & ~31) + perm32(R & 31)) : R;
        voffA[i] = (unsigned)(R * K + C) * 2u; voffB[i] = (unsigned)(Rb * K + C) * 2u; }
    const size_t kstep = (size_t)(BK * 2);
    const size_t hstep = (size_t)HALF * K * 2;
    const size_t tstep = 2 * hstep;
    const unsigned ldsw = (unsigned)wid * 1024u;
    const int aoff = lds_byte(wr * 64 + fr, fq * 8), boff = lds_byte(wc * 32 + fr, fq * 8);
#define PG8_SA(b, h) (((b) * 2 + (h)) * HTB)
#define PG8_SB(b, h) ((4 + (b) * 2 + (h)) * HTB)
#define PG8_STAGE(bufoff, gbase, voff) do { _Pragma("unroll") for (int _i = 0; _i < 2; ++_i) \
        __builtin_amdgcn_global_load_lds((const unsigned*)((const char*)(gbase) + (voff)[_i]), (PG8_LAS unsigned*)(lds + (bufoff) + ldsw + _i * 8192), 16, 0, 0); } while (0)
#define PG8_LDA(dst, b, h) do { _Pragma("unroll") for (int m = 0; m < 4; ++m) _Pragma("unroll") for (int k = 0; k < 2; ++k) dst[m][k] = *(const PG8_LAS bf16x8*)(lds + PG8_SA(b, h) + aoff + m * 2048 + k * 1024); } while (0)
#define PG8_LDB(dst, b, h) do { _Pragma("unroll") for (int n = 0; n < 2; ++n) _Pragma("unroll") for (int k = 0; k < 2; ++k) dst[n][k] = *(const PG8_LAS bf16x8*)(lds + PG8_SB(b, h) + boff + n * 2048 + k * 1024); } while (0)
#define PG8_MMA(ai, bj, At, Bt) do { __builtin_amdgcn_s_setprio(1); _Pragma("unroll") for (int m = 0; m < 4; ++m) _Pragma("unroll") for (int n = 0; n < 2; ++n) _Pragma("unroll") for (int k = 0; k < 2; ++k) \
        acc[ai][bj][m][n] = __builtin_amdgcn_mfma_f32_16x16x32_bf16(Bt[n][k], At[m][k], acc[ai][bj][m][n], 0, 0, 0); __builtin_amdgcn_s_setprio(0); } while (0)
#define PG8_WAIT_V(n) asm volatile("s_waitcnt vmcnt(" #n ")" ::: "memory")
#define PG8_WAIT_L(n) asm volatile("s_waitcnt lgkmcnt(" #n ")" ::: "memory")
#define PG8_BAR __builtin_amdgcn_s_barrier()
#define PG8_SCHED __builtin_amdgcn_sched_barrier(0)
    Unit cur, nxt; int ui = 0;
    if (!S.next(0, cur)) return;
    f32x4 acc[2][2][4][2];
#pragma unroll
    for (int a = 0; a < 2; ++a)
#pragma unroll
        for (int b = 0; b < 2; ++b)
#pragma unroll
            for (int m = 0; m < 4; ++m)
#pragma unroll
                for (int n = 0; n < 2; ++n) acc[a][b][m][n] = (f32x4){0.f, 0.f, 0.f, 0.f};
    bf16x8 At[4][2], B0[2][2], B1[2][2];
    const char* cA = (const char*)g.A + (size_t)cur.pm * tstep; const char* cB = (const char*)g.Bt + (size_t)cur.pn * tstep;
    S.a_ready(cur);
    if constexpr (SP2) {
        PG8_STAGE(PG8_SB(0, 0), cB, voffB); PG8_STAGE(PG8_SB(0, 1), cB + hstep, voffB); PG8_STAGE(PG8_SA(0, 0), cA, voffA); PG8_STAGE(PG8_SA(0, 1), cA + hstep, voffA);
        if (wr == 1) PG8_BAR;
        PG8_WAIT_V(2); PG8_BAR;
        PG8_STAGE(PG8_SB(1, 0), cB + kstep, voffB); PG8_STAGE(PG8_SA(1, 0), cA + kstep, voffA); PG8_STAGE(PG8_SB(1, 1), cB + hstep + kstep, voffB);
        PG8_WAIT_V(6); PG8_BAR;
    } else {
        PG8_STAGE(PG8_SB(0, 0), cB, voffB); PG8_STAGE(PG8_SA(0, 0), cA, voffA); PG8_STAGE(PG8_SB(0, 1), cB + hstep, voffB); PG8_STAGE(PG8_SA(0, 1), cA + hstep, voffA);
        if (wr == 1) PG8_BAR;
        PG8_WAIT_V(4); PG8_BAR;
        PG8_STAGE(PG8_SB(1, 0), cB + kstep, voffB); PG8_STAGE(PG8_SA(1, 0), cA + kstep, voffA); PG8_STAGE(PG8_SB(1, 1), cB + hstep + kstep, voffB);
        PG8_WAIT_V(6); PG8_BAR;
    }
    for (;;) {
        const bool has_next = S.next(ui + 1, nxt);
        const char* nA = has_next ? (const char*)g.A + (size_t)nxt.pm * tstep : cA; const char* nB = has_next ? (const char*)g.Bt + (size_t)nxt.pn * tstep : cB;
        for (int t = 0; t < nt; t += 2) {
            const bool last = (t == nt - 2);
            const char* a1 = cA + (size_t)(t + 1) * kstep;
            const char* a2 = last ? nA : cA + (size_t)(t + 2) * kstep; const char* b2 = last ? nB : cB + (size_t)(t + 2) * kstep;
            const char* a3 = a2 + kstep; const char* b3 = b2 + kstep;
            if (last && has_next) S.a_ready(nxt);
            if (last) E.prefetch(cur, wid, lane);
            if constexpr (SP2) {
            PG8_LDB(B0, 0, 0); PG8_LDB(B1, 0, 1); PG8_SCHED; PG8_LDA(At, 0, 0); PG8_STAGE(PG8_SA(1, 1), a1 + hstep, voffA);
            PG8_WAIT_V(8); PG8_WAIT_L(0); PG8_BAR; PG8_MMA(0, 0, At, B0); PG8_MMA(0, 1, At, B1); PG8_BAR; PG8_SCHED;
            PG8_LDA(At, 0, 1); PG8_STAGE(PG8_SB(0, 0), b2, voffB); PG8_STAGE(PG8_SB(0, 1), b2 + hstep, voffB); PG8_STAGE(PG8_SA(0, 0), a2, voffA);
            PG8_WAIT_V(8); PG8_WAIT_L(0); PG8_BAR; PG8_MMA(1, 0, At, B0); PG8_MMA(1, 1, At, B1); PG8_BAR; PG8_SCHED;
            PG8_LDB(B0, 1, 0); PG8_LDB(B1, 1, 1); PG8_SCHED; PG8_LDA(At, 1, 0); PG8_STAGE(PG8_SA(0, 1), a2 + hstep, voffA);
            PG8_WAIT_V(8); PG8_WAIT_L(0); PG8_BAR; PG8_MMA(0, 0, At, B0); PG8_MMA(0, 1, At, B1); PG8_BAR; PG8_SCHED;
            PG8_LDA(At, 1, 1); PG8_STAGE(PG8_SB(1, 0), b3, voffB); PG8_STAGE(PG8_SB(1, 1), b3 + hstep, voffB); PG8_STAGE(PG8_SA(1, 0), a3, voffA);
            PG8_WAIT_V(8); PG8_WAIT_L(0); PG8_BAR; PG8_MMA(1, 0, At, B0); PG8_MMA(1, 1, At, B1); PG8_BAR; PG8_SCHED;
            } else {
            PG8_LDB(B0, 0, 0); PG8_SCHED; PG8_LDA(At, 0, 0); PG8_STAGE(PG8_SA(1, 1), a1 + hstep, voffA);
            PG8_WAIT_L(8); PG8_BAR; PG8_WAIT_L(0); PG8_MMA(0, 0, At, B0); PG8_BAR; PG8_SCHED;
            PG8_LDB(B1, 0, 1); PG8_STAGE(PG8_SB(0, 0), b2, voffB);
            PG8_BAR; PG8_WAIT_L(0); PG8_MMA(0, 1, At, B1); PG8_BAR;
            PG8_LDA(At, 0, 1); PG8_STAGE(PG8_SA(0, 0), a2, voffA);
            PG8_BAR; PG8_WAIT_L(0); PG8_MMA(1, 0, At, B0); PG8_BAR; PG8_SCHED;
            PG8_STAGE(PG8_SB(0, 1), b2 + hstep, voffB);
            PG8_WAIT_V(6); PG8_BAR; PG8_MMA(1, 1, At, B1); PG8_BAR;
            PG8_LDB(B0, 1, 0); PG8_SCHED; PG8_LDA(At, 1, 0); PG8_STAGE(PG8_SA(0, 1), a2 + hstep, voffA);
            PG8_WAIT_L(8); PG8_BAR; PG8_WAIT_L(0); PG8_MMA(0, 0, At, B0); PG8_BAR; PG8_SCHED;
            PG8_LDB(B1, 1, 1); PG8_STAGE(PG8_SB(1, 0), b3, voffB);
            PG8_BAR; PG8_WAIT_L(0); PG8_MMA(0, 1, At, B1); PG8_BAR;
            PG8_LDA(At, 1, 1); PG8_STAGE(PG8_SA(1, 0), a3, voffA);
            PG8_BAR; PG8_WAIT_L(0); PG8_MMA(1, 0, At, B0); PG8_BAR; PG8_SCHED;
            PG8_STAGE(PG8_SB(1, 1), b3 + hstep, voffB);
            PG8_WAIT_V(6); PG8_BAR; PG8_MMA(1, 1, At, B1); PG8_BAR;
            }
        }
        if constexpr (ALIGN_EPI) { if (wr == 0) PG8_BAR; }
        if constexpr (!Epi::AFTER_DRAIN) { E(acc, cur, wr, wc, fr, fq); S.done(cur); }
        if (!has_next) break;
#pragma unroll
        for (int a = 0; a < 2; ++a)
#pragma unroll
            for (int b = 0; b < 2; ++b)
#pragma unroll
                for (int m = 0; m < 4; ++m)
#pragma unroll
                    for (int n = 0; n < 2; ++n) acc[a][b][m][n] = (f32x4){0.f, 0.f, 0.f, 0.f};
        cur = nxt; cA = nA; cB = nB; ++ui;
        if constexpr (ALIGN_EPI) { if (wr == 1) PG8_BAR; }
    }
    PG8_WAIT_V(0);
    if constexpr (!ALIGN_EPI) { if (wr == 0) PG8_BAR; }
    PG8_BAR;
    if constexpr (Epi::AFTER_DRAIN) { E.fused(acc, cur, wr, wc, fr, fq, lds, wid, lane); S.done(cur); }
#undef PG8_SA
#undef PG8_SB
#undef PG8_STAGE
#undef PG8_LDA
#undef PG8_LDB
#undef PG8_MMA
#undef PG8_WAIT_V
#undef PG8_WAIT_L
#undef PG8_BAR
#undef PG8_SCHED
}
}

#ifndef PG8_SP2
#define PG8_SP2 true
#endif
#ifndef PG8_ALIGN
#define PG8_ALIGN true
#endif

constexpr size_t MiB = 1u << 20;
constexpr size_t WS_CTL = 0, CTL_ZERO_BYTES = 64 * 1024;
constexpr size_t WS_ROWSS = 1 * MiB;
constexpr size_t WS_W = 2 * MiB, W_LAYER = 41 * MiB;
constexpr size_t WO_GU1 = 0, WO_D1 = 11 * MiB, WO_IN = 17 * MiB, WO_OUT = 22 * MiB, WO_GU2 = 24 * MiB, WO_D2 = 35 * MiB, WO_S = 40 * MiB + 512 * 1024, WO_RSW = WO_S + 4 * 128 * 128 * 2;
constexpr size_t WS_XB = 84 * MiB;
constexpr size_t WS_HID = 148 * MiB;
constexpr size_t WS_PACT = 148 * MiB, WS_MIX = 252 * MiB;
constexpr size_t WS_END = 324 * MiB;
static_assert(WO_D1 >= (size_t)NGU * D * 2 && WO_IN - WO_D1 >= (size_t)D * FF * 2 && WO_OUT - WO_IN >= (size_t)NIN * D * 2 && WO_S - WO_D2 >= (size_t)D * FF * 2 && WO_RSW + 4 * 128 * 4 <= W_LAYER, "weight map");
static_assert(WS_W + DEPTH * W_LAYER <= WS_XB && WS_XB + (size_t)M * D * 2 <= WS_HID && WS_HID + (size_t)M * FF * 2 <= WS_END && WS_PACT + (size_t)M * PACT_W * 2 <= WS_MIX && WS_MIX + (size_t)M * D * 2 <= WS_END, "d_ws map");
constexpr int CW_BAR = 1024;

constexpr int RING_OFF = 0, RING_BYTES = 131072;
constexpr int LDSCTL_OFF = RING_BYTES, MISC_OFF = LDSCTL_OFF + 320;
constexpr int RSTBL_OFF = RING_BYTES + 2048;
constexpr int LDS_BYTES = 163840;
static_assert(MISC_OFF + 128 <= LDS_BYTES, "LDS map");

#define GAS __attribute__((address_space(1)))
#define LAS __attribute__((address_space(3)))
typedef unsigned short bf16;
typedef unsigned v4u __attribute__((ext_vector_type(4)));
typedef unsigned v2u __attribute__((ext_vector_type(2)));
typedef float f32x4 __attribute__((ext_vector_type(4)));
typedef short bf16x8 __attribute__((ext_vector_type(8)));
typedef short s16x4 __attribute__((ext_vector_type(4)));
typedef GAS unsigned gu32;
#define RLX_AGENT __ATOMIC_RELAXED, __HIP_MEMORY_SCOPE_AGENT
#define LDS_WAIT() asm volatile("s_waitcnt lgkmcnt(0)" ::: "memory")
#define VM_WAIT() asm volatile("s_waitcnt vmcnt(0)" ::: "memory")
__device__ __forceinline__ unsigned f2bf(float f) { unsigned u = __builtin_bit_cast(unsigned, f); return (u + 0x7fffu + ((u >> 16) & 1u)) >> 16; }
__device__ __forceinline__ unsigned pk2(float lo, float hi) { return f2bf(lo) | (f2bf(hi) << 16); }
__device__ __forceinline__ float bflo(unsigned w) { return __uint_as_float(w << 16); }
__device__ __forceinline__ float bfhi(unsigned w) { return __uint_as_float(w & 0xffff0000u); }
__device__ __forceinline__ float sigm(float x) { return __builtin_amdgcn_rcpf(1.0f + __builtin_amdgcn_exp2f(-1.4426950408889634f * x)); }

#define XB_TMO      128
#define XB_XCNT(j)  (256  + 64 * (j))
#define XB_XSUB(j)  (1280 + 64 * (j))
#define XB_XGEN(j)  (2304 + 64 * (j))
#define XB_TOP      3328
#define XB_TOPGEN   3392
#define XCD_BAR_WORDS 3456
#define XB_SPIN_CAP (1u << 18)

__device__ __forceinline__ unsigned xb_ld(unsigned* p)              { return __hip_atomic_load(p, __ATOMIC_RELAXED, __HIP_MEMORY_SCOPE_AGENT); }
__device__ __forceinline__ unsigned xb_add(unsigned* p, unsigned v) { return __hip_atomic_fetch_add(p, v, __ATOMIC_RELAXED, __HIP_MEMORY_SCOPE_AGENT); }
__device__ __forceinline__ unsigned xb_xcc_id() { return (unsigned)__builtin_amdgcn_s_getreg((3 << 11) | 20) & 0xFu; }
#define XB_SPIN(cond, bar) do { unsigned _sp = 0; while (cond) { __builtin_amdgcn_s_sleep(1); \
    if ((++_sp & 255u) == 0u) { if (xb_ld(&(bar)[XB_TMO])) break; if (_sp > XB_SPIN_CAP) { atomicAdd(&(bar)[XB_TMO], 1u); break; } } } } while (0)

struct XcdBarrier {
    unsigned* bar; unsigned x;
    volatile LAS unsigned* st;
};

__device__ __forceinline__ XcdBarrier xcd_barrier_post(unsigned* bar, volatile LAS unsigned* st) {
    XcdBarrier b; b.bar = bar; b.x = xb_xcc_id(); b.st = st;
    if (threadIdx.x == 0) (void)xb_add(&bar[XB_XCNT(b.x)], 1u);
    return b;
}
__device__ __forceinline__ void xcd_barrier_complete(unsigned* bar, unsigned x, unsigned& nloc, unsigned& nx) {
    const unsigned G = gridDim.x * gridDim.y * gridDim.z;
    unsigned sum, cnt, mine, sp = 0u;
    for (;;) {
        sum = 0u; cnt = 0u; mine = 0u;
#pragma unroll
        for (unsigned j = 0; j < 16; ++j) { const unsigned c = xb_ld(&bar[XB_XCNT(j)]); sum += c; cnt += (c > 0u) ? 1u : 0u; mine = (j == x) ? c : mine; }
        if (sum == G) break;
        __builtin_amdgcn_s_sleep(1);
        if ((++sp & 255u) == 0u) { if (xb_ld(&bar[XB_TMO])) break; if (sp > XB_SPIN_CAP) { atomicAdd(&bar[XB_TMO], 1u); break; } }
    }
    nloc = mine > 0u ? mine : 1u; nx = cnt > 0u ? cnt : 1u;
}

__device__ __forceinline__ void xcd_barrier(const XcdBarrier& b) {
    asm volatile("s_waitcnt vmcnt(0)" ::: "memory");
    __syncthreads();
    if (threadIdx.x == 0) {
        unsigned* bar = b.bar;
        __builtin_amdgcn_s_waitcnt(0);
        unsigned nloc = b.st[0], nx = b.st[1];
        if (nloc == 0u) { xcd_barrier_complete(bar, b.x, nloc, nx); b.st[0] = nloc; b.st[1] = nx; }
        const unsigned old = xb_add(&bar[XB_XSUB(b.x)], 1u);
        const unsigned gen = old / nloc;
        if (old + 1u == (gen + 1u) * nloc) {
            __builtin_amdgcn_fence(__ATOMIC_RELEASE, "agent");
            asm volatile("s_waitcnt vmcnt(0)" ::: "memory");
            const unsigned og = xb_add(&bar[XB_TOP], 1u);
            const unsigned tg = og / nx;
            if (og + 1u == (tg + 1u) * nx) xb_add(&bar[XB_TOPGEN], 1u);
            else XB_SPIN(xb_ld(&bar[XB_TOPGEN]) == tg, bar);
            __builtin_amdgcn_fence(__ATOMIC_ACQUIRE, "agent");
            xb_add(&bar[XB_XGEN(b.x)], 1u);
            asm volatile("s_waitcnt vmcnt(0)" ::: "memory");
        } else {
            XB_SPIN(xb_ld(&bar[XB_XGEN(b.x)]) == gen, bar);
            __builtin_amdgcn_fence(__ATOMIC_ACQUIRE, "agent");
            asm volatile("s_waitcnt vmcnt(0)" ::: "memory");
        }
    }
    __syncthreads();
}

struct Frame {
    LAS unsigned char* lds;
    volatile LAS unsigned* MISC;
    gu32* ctl;
    int tid, lane, wave, G;
};
struct Args { const float* in[22]; float* out; unsigned char* ws; int ph_lo, ph_hi; };
#define LAUNDER_S(p) asm volatile("" : "+s"(p))
__device__ __forceinline__ float wave_sum(float v) {
#pragma unroll
    for (int o = 1; o < 64; o <<= 1) v += __shfl_xor(v, o);
    return v;
}
enum { I_X = 0, I_N1, I_G1, I_U1, I_D1, I_NM, I_WIN, I_CAW, I_CAB, I_LAG, I_LAB, I_LVG, I_LVB, I_WS, I_BS, I_CCW, I_WOUT, I_N2, I_G2, I_U2, I_D2, I_NF };

__device__ __forceinline__ void p0_transpose_item(const float* W, int N, int K, bf16* WT, int dest_row0, const float* gain, LAS float* scr, int k0, int n0, int lane) {
    const GAS float* wp = (const GAS float*)W + (size_t)(k0 + (lane >> 5)) * N + n0 + (lane & 31);
    float v[32];
#pragma unroll
    for (int i = 0; i < 32; ++i) { v[i] = *wp; wp += 2 * N; }
    const int c = lane & 7;
    f32x4 g0 = (f32x4){1.f, 1.f, 1.f, 1.f}, g1 = g0;
    if (gain) { g0 = *(const GAS f32x4*)(gain + k0 + 8 * c); g1 = *(const GAS f32x4*)(gain + k0 + 8 * c + 4); }
#pragma unroll
    for (int i = 0; i < 32; ++i) scr[(2 * i + (lane >> 5)) * 33 + (lane & 31)] = v[i];
    LDS_WAIT(); asm volatile("" ::: "memory");
#pragma unroll
    for (int j = 0; j < 4; ++j) { const int n = (lane >> 3) + 8 * j; const LAS float* s = scr + (8 * c) * 33 + n;
        v4u o; o.x = pk2(s[0 * 33] * g0[0], s[1 * 33] * g0[1]); o.y = pk2(s[2 * 33] * g0[2], s[3 * 33] * g0[3]); o.z = pk2(s[4 * 33] * g1[0], s[5 * 33] * g1[1]); o.w = pk2(s[6 * 33] * g1[2], s[7 * 33] * g1[3]);
        *(GAS v4u*)(WT + (size_t)(dest_row0 + n) * K + k0 + 8 * c) = o; }
    LDS_WAIT(); asm volatile("" ::: "memory");
}
__device__ __forceinline__ int map_gu(int n0, int up) { return (n0 >> 7) * 256 + (n0 & 127) + (up ? 128 : 0); }
__device__ __forceinline__ int map_in(int n) {
    if (n < 384) return (n >> 7) * 256 + (n & 127);
    if (n < 768) { const int r = n - 384; return (r >> 7) * 256 + 128 + (r & 127); }
    if (n < 1280) return n;
    if (n < 1664) return 2048 + (n - 1280);
    if (n < 2048) { const int r = n - 1664; return 1280 + (r >> 7) * 256 + (r & 127); }
    { const int r = n - 2048; return 1280 + (r >> 7) * 256 + 128 + (r & 127); }
}
__device__ __forceinline__ void p0_prologue(Frame& F, const Args& A) {
    unsigned char* ws = A.ws; LAUNDER_S(ws);
    LAS float* scr = (LAS float*)(F.lds + RING_OFF + F.wave * 16384);
    const int gw = blockIdx.x * NWAVES + F.wave, NGW = F.G * NWAVES, lane = F.lane;
    constexpr int I_GU = (D / 64) * (FF / 32), I_DN = (FF / 64) * (D / 32), I_IN = (D / 64) * (DPROJ / 32), I_OUT = (D / 64) * (D / 32);
    constexpr int PER_LAYER = 4 * I_GU + 2 * I_DN + I_IN + I_OUT;
    for (int it = gw; it < DEPTH * PER_LAYER; it += NGW) {
        const int l = it / PER_LAYER; int r = it % PER_LAYER;
        unsigned char* wl = ws + WS_W + (size_t)l * W_LAYER;
        const float* W; const float* gain = nullptr; bf16* WT; int N, K, mode;
        if (r < I_GU) { W = A.in[I_G1] + (size_t)l * D * FF; gain = A.in[I_N1] + l * D; WT = (bf16*)(wl + WO_GU1); N = FF; K = D; mode = 1; }
        else if ((r -= I_GU) < I_GU) { W = A.in[I_U1] + (size_t)l * D * FF; gain = A.in[I_N1] + l * D; WT = (bf16*)(wl + WO_GU1); N = FF; K = D; mode = 2; }
        else if ((r -= I_GU) < I_DN) { W = A.in[I_D1] + (size_t)l * D * FF; WT = (bf16*)(wl + WO_D1); N = D; K = FF; mode = 0; }
        else if ((r -= I_DN) < I_IN) { W = A.in[I_WIN] + (size_t)l * D * DPROJ; gain = A.in[I_NM] + l * D; WT = (bf16*)(wl + WO_IN); N = DPROJ; K = D; mode = 3; }
        else if ((r -= I_IN) < I_OUT) { W = A.in[I_WOUT] + (size_t)l * D * D; WT = (bf16*)(wl + WO_OUT); N = D; K = D; mode = 0; }
        else if ((r -= I_OUT) < I_GU) { W = A.in[I_G2] + (size_t)l * D * FF; gain = A.in[I_N2] + l * D; WT = (bf16*)(wl + WO_GU2); N = FF; K = D; mode = 1; }
        else if ((r -= I_GU) < I_GU) { W = A.in[I_U2] + (size_t)l * D * FF; gain = A.in[I_N2] + l * D; WT = (bf16*)(wl + WO_GU2); N = FF; K = D; mode = 2; }
        else { r -= I_GU; W = A.in[I_D2] + (size_t)l * D * FF; WT = (bf16*)(wl + WO_D2); N = D; K = FF; mode = 0; }
        const int nblk = N / 32, kb = r / nblk, nb = r % nblk, k0 = 64 * kb, n0 = 32 * nb;
        const int dr = mode == 0 ? n0 : (mode == 3 ? map_in(n0) : map_gu(n0, mode == 2));
        p0_transpose_item(W, N, K, WT, dr, gain, scr, k0, n0, lane);
    }
    const int gt = blockIdx.x * (NWAVES * 64) + F.tid, NGT = F.G * NWAVES * 64;
    for (int i = gt; i < DEPTH * 128 * D / 8; i += NGT) { const int l = i / (128 * D / 8), r = i % (128 * D / 8);
        *(GAS v4u*)(ws + WS_W + (size_t)l * W_LAYER + WO_IN + (size_t)DPROJ * D * 2 + (size_t)r * 16) = (v4u){0u, 0u, 0u, 0u}; }
    for (int r = gw; r < DEPTH * 4 * 128; r += NGW) { const int l = r >> 9, rr = r & 511, t = rr & 127; float sum = 0.f;
        GAS bf16* wm = (GAS bf16*)(ws + WS_W + (size_t)l * W_LAYER + WO_S) + (size_t)rr * 128;
#pragma unroll
        for (int i = 0; i < 2; ++i) { const int sidx = lane + 64 * i; const unsigned mb = sidx <= t ? f2bf(A.in[I_WS][(size_t)r * 128 + sidx]) : 0u; wm[sidx] = (bf16)mb; sum += __uint_as_float(mb << 16); }
        sum = wave_sum(sum);
        if (lane == 0) ((GAS float*)(ws + WS_W + (size_t)l * W_LAYER + WO_RSW))[rr] = sum; }
    GAS float* rowss = (GAS float*)(ws + WS_ROWSS);
    for (int i = gt; i < 6 * M; i += NGT) rowss[M + i] = 0.f;
    const float* x = A.in[I_X]; GAS bf16* xb = (GAS bf16*)(ws + WS_XB);
    for (int m0 = gw * 4; m0 < M; m0 += NGW * 4) {
        f32x4 v[4][4]; float sq[4];
#pragma unroll
        for (int r = 0; r < 4; ++r) { const GAS f32x4* xr = (const GAS f32x4*)(x + (size_t)(m0 + r) * D) + lane;
#pragma unroll
            for (int j = 0; j < 4; ++j) v[r][j] = xr[64 * j]; }
#pragma unroll
        for (int r = 0; r < 4; ++r) { float s = 0.f;
#pragma unroll
            for (int j = 0; j < 4; ++j) s += (v[r][j].x * v[r][j].x + v[r][j].y * v[r][j].y) + (v[r][j].z * v[r][j].z + v[r][j].w * v[r][j].w);
            sq[r] = s; }
#pragma unroll
        for (int o = 1; o < 64; o <<= 1) {
#pragma unroll
            for (int r = 0; r < 4; ++r) sq[r] += __shfl_xor(sq[r], o); }
#pragma unroll
        for (int r = 0; r < 4; ++r) { GAS v2u* o8 = (GAS v2u*)(xb + (size_t)(m0 + r) * D) + lane;
#pragma unroll
            for (int j = 0; j < 4; ++j) o8[64 * j] = (v2u){pk2(v[r][j].x, v[r][j].y), pk2(v[r][j].z, v[r][j].w)}; }
        if (lane < 4) rowss[m0 + lane] = lane == 0 ? sq[0] : (lane == 1 ? sq[1] : (lane == 2 ? sq[2] : sq[3]));
    }
}

__device__ __forceinline__ void final_phase(Frame& F, const Args& A) {
    unsigned char* ws = A.ws; LAUNDER_S(ws);
    const int gw = blockIdx.x * NWAVES + F.wave, NGW = F.G * NWAVES, lane = F.lane;
    const GAS float* rowss = (const GAS float*)(ws + WS_ROWSS) + 6 * (size_t)M; const float* g = A.in[I_NF]; const GAS bf16* xb = (const GAS bf16*)(ws + WS_XB);
    f32x4 gv[4];
#pragma unroll
    for (int j = 0; j < 4; ++j) gv[j] = *((const f32x4*)g + lane + 64 * j);
    for (int m0 = gw * 4; m0 < M; m0 += NGW * 4) {
        v2u xv[4][4]; float rs[4];
#pragma unroll
        for (int r = 0; r < 4; ++r) { rs[r] = rowss[m0 + r]; const GAS v2u* xr = (const GAS v2u*)(xb + (size_t)(m0 + r) * D) + lane;
#pragma unroll
            for (int j = 0; j < 4; ++j) xv[r][j] = xr[64 * j]; }
#pragma unroll
        for (int r = 0; r < 4; ++r) { const float sc = __builtin_amdgcn_rsqf(rs[r] * (1.0f / 1024.0f) + RMS_EPS); GAS f32x4* orow = (GAS f32x4*)(A.out + (size_t)(m0 + r) * D) + lane;
#pragma unroll
            for (int j = 0; j < 4; ++j) { const f32x4 v = (f32x4){bflo(xv[r][j].x), bfhi(xv[r][j].x), bflo(xv[r][j].y), bfhi(xv[r][j].y)}; orow[64 * j] = v * sc * gv[j]; } }
    }
}

constexpr int TA_ROW = 784;
constexpr int ST_OFF = 158 * TA_ROW;
constexpr int HOLD_OFF = RING_BYTES + 2048;
constexpr int VT_STR = 132;
static_assert(ST_OFF + 1024 <= RING_BYTES && 256 * VT_STR * 2 <= RING_BYTES && HOLD_OFF + 32 * TA_ROW <= LDS_BYTES, "mixer LDS");
typedef float f32x2 __attribute__((ext_vector_type(2)));
__device__ __forceinline__ float quad_sum(float v) {
    v += __builtin_bit_cast(float, __builtin_amdgcn_update_dpp(0, __builtin_bit_cast(int, v), 0xB1, 0xF, 0xF, true));
    v += __builtin_bit_cast(float, __builtin_amdgcn_update_dpp(0, __builtin_bit_cast(int, v), 0x4E, 0xF, 0xF, true));
    return v;
}
__device__ __forceinline__ void mixer_c_item(const GAS bf16* P, GAS bf16* MX, const float* ccw, int tok0, int pos0, int it) {
    const int t = it / 48, c8 = it % 48; const int pos = pos0 + t;
    const GAS bf16* base = P + (size_t)(tok0 + t) * PACT_W;
    const v4u x0 = *(const GAS v4u*)(base + P_CX + c8 * 8); v4u x1 = (v4u){0u, 0u, 0u, 0u}, x2 = x1;
    if (pos >= 1) x1 = *(const GAS v4u*)(base - PACT_W + P_CX + c8 * 8);
    if (pos >= 2) x2 = *(const GAS v4u*)(base - 2 * PACT_W + P_CX + c8 * 8);
    const v4u cb = *(const GAS v4u*)(base + P_CB + c8 * 8);
    const f32x4 w0a = *(const f32x4*)(ccw + 0 * DC + c8 * 8), w0b = *(const f32x4*)(ccw + 0 * DC + c8 * 8 + 4);
    const f32x4 w1a = *(const f32x4*)(ccw + 1 * DC + c8 * 8), w1b = *(const f32x4*)(ccw + 1 * DC + c8 * 8 + 4);
    const f32x4 w2a = *(const f32x4*)(ccw + 2 * DC + c8 * 8), w2b = *(const f32x4*)(ccw + 2 * DC + c8 * 8 + 4);
    v4u o;
#pragma unroll
    for (int e = 0; e < 4; ++e) {
        const float wl0 = e < 2 ? w0a[2 * e] : w0b[2 * e - 4], wh0 = e < 2 ? w0a[2 * e + 1] : w0b[2 * e - 3];
        const float wl1 = e < 2 ? w1a[2 * e] : w1b[2 * e - 4], wh1 = e < 2 ? w1a[2 * e + 1] : w1b[2 * e - 3];
        const float wl2 = e < 2 ? w2a[2 * e] : w2b[2 * e - 4], wh2 = e < 2 ? w2a[2 * e + 1] : w2b[2 * e - 3];
        const float lo_ = bflo(cb[e]) * (wl0 * bflo(x2[e]) + wl1 * bflo(x1[e]) + wl2 * bflo(x0[e]));
        const float hi_ = bfhi(cb[e]) * (wh0 * bfhi(x2[e]) + wh1 * bfhi(x1[e]) + wh2 * bfhi(x0[e]));
        o[e] = pk2(lo_, hi_); }
    *(GAS v4u*)(MX + (size_t)(tok0 + t) * D + MIX_C + c8 * 8) = o;
}
__device__ __forceinline__ void mixer_phase(Frame& F, const Args& A, int l) {
    unsigned char* ws = A.ws; LAUNDER_S(ws);
    int tid_ = threadIdx.x; asm volatile("" : "+v"(tid_)); const int tid = tid_, lane = tid & 63, wave = F.wave;
    const GAS bf16* P = (const GAS bf16*)(ws + WS_PACT); GAS bf16* MX = (GAS bf16*)(ws + WS_MIX);
    const float* caw = A.in[I_CAW] + l * 31 * DA; const float* cab = A.in[I_CAB] + l * DA;
    const float* lag = A.in[I_LAG] + l * DA; const float* lab = A.in[I_LAB] + l * DA;
    const float* lvg = A.in[I_LVG] + l * DB; const float* lvb = A.in[I_LVB] + l * DB;
    const float* bs = A.in[I_BS] + l * 4 * CHUNK; const float* ccw = A.in[I_CCW] + l * 3 * DC;
    const GAS bf16* Wm = (const GAS bf16*)(ws + WS_W + (size_t)l * W_LAYER + WO_S);
    const GAS float* RSW = (const GAS float*)(ws + WS_W + (size_t)l * W_LAYER + WO_RSW);
    LAS unsigned char* T = F.lds + RING_OFF;
    LAS f32x2* ST = (LAS f32x2*)(T + ST_OFF);
    for (int q = blockIdx.x; q < NCHUNK; q += F.G) {
        const int tok0 = q * CHUNK; const int pos0 = (q & 15) * CHUNK;
        for (int p = tid; p < 158 * 48; p += NWAVES * 64) { const int j = p / 48, c8 = p % 48; v4u v = (v4u){0u, 0u, 0u, 0u};
            if (pos0 + j >= 30) v = *(const GAS v4u*)(P + (size_t)(tok0 - 30 + j) * PACT_W + P_GLU + c8 * 8);
            *(LAS v4u*)(T + j * TA_ROW + c8 * 16) = v; }
        __syncthreads();
        if (wave < 6) {
            const int half = wave >= 3 ? 1 : 0, p = tid - half * 192; f32x2 w2[31];
#pragma unroll
            for (int k = 0; k < 31; ++k) w2[k] = *(const f32x2*)(caw + k * DA + 2 * p);
            const f32x2 bias2 = *(const f32x2*)(cab + 2 * p);
            LAS unsigned char* colp = T + 4 * p;
#define CONV_LOOP(NB, RD, WR) do { LAS unsigned char* rd_ = (RD); LAS unsigned char* wr_ = (WR); \
                _Pragma("unroll 1") for (int tb = 0; tb < (NB); ++tb, rd_ += 4 * TA_ROW, wr_ += 4 * TA_ROW) { f32x2 in2[34]; \
                    _Pragma("unroll") for (int i = 0; i < 34; ++i) { const unsigned wd = *(const LAS unsigned*)(rd_ + i * TA_ROW); in2[i] = (f32x2){bflo(wd), bfhi(wd)}; } \
                    _Pragma("unroll") for (int i = 0; i < 4; ++i) { f32x2 o = bias2; _Pragma("unroll") for (int k = 0; k < 31; ++k) o = w2[k] * in2[i + k] + o; *(LAS unsigned*)(wr_ + i * TA_ROW) = pk2(o.x, o.y); } } } while (0)
            if (half == 0) { CONV_LOOP(16, colp, colp); }
            else { CONV_LOOP(8, colp + 64 * TA_ROW, F.lds + HOLD_OFF + 4 * p); CONV_LOOP(8, colp + 96 * TA_ROW, colp + 96 * TA_ROW); }
#undef CONV_LOOP
        }
        for (int v = (wave >= 6 ? 0 : 32); v < 36; ++v) { const int it = v < 32 ? (tid - 6 * 64) + 128 * v : 4096 + tid + NWAVES * 64 * (v - 32);
            mixer_c_item(P, MX, ccw, tok0, pos0, it); }
        __syncthreads();
        {
            const int t = tid >> 2, qq = tid & 3; const LAS unsigned char* rp = ((t >= 64 && t < 96) ? (F.lds + HOLD_OFF + (t - 64) * TA_ROW) : (T + t * TA_ROW)) + qq * 192; float s = 0.f, s2 = 0.f;
#pragma unroll
            for (int j = 0; j < 12; ++j) { const v4u d = *(const LAS v4u*)(rp + 16 * j);
#pragma unroll
                for (int e = 0; e < 4; ++e) { const float lo = bflo(d[e]), hi = bfhi(d[e]); s += lo + hi; s2 += lo * lo + hi * hi; } }
            s = quad_sum(s); s2 = quad_sum(s2);
            const float mean = s * (1.0f / DA), var = s2 * (1.0f / DA) - mean * mean;
            if (qq == 0) ST[t] = (f32x2){mean, __builtin_amdgcn_rsqf(fmaxf(var, 0.f) + LN_EPS)};
        }
        __syncthreads();
        {
            float g6[6], b6[6];
#pragma unroll
            for (int j = 0; j < 3; ++j) { const f32x2 gg = *(const f32x2*)(lag + 2 * lane + 128 * j), bb = *(const f32x2*)(lab + 2 * lane + 128 * j); g6[2 * j] = gg.x; g6[2 * j + 1] = gg.y; b6[2 * j] = bb.x; b6[2 * j + 1] = bb.y; }
#pragma unroll 4
            for (int tt = 0; tt < 16; ++tt) { const int t = wave * 16 + tt; const f32x2 st = ST[t]; const LAS unsigned char* rowp = (t >= 64 && t < 96) ? (F.lds + HOLD_OFF + (t - 64) * TA_ROW) : (T + t * TA_ROW);
#pragma unroll
                for (int j = 0; j < 3; ++j) { const unsigned wd = *(const LAS unsigned*)(rowp + 4 * lane + 256 * j);
                    const float y0 = (bflo(wd) - st.x) * st.y * g6[2 * j] + b6[2 * j], y1 = (bfhi(wd) - st.x) * st.y * g6[2 * j + 1] + b6[2 * j + 1];
                    *(GAS unsigned*)(MX + (size_t)(tok0 + t) * D + MIX_A + 2 * lane + 128 * j) = pk2(y0 * sigm(y0), y1 * sigm(y1)); }
            }
        }
        v4u xv[8];
        {   const int t = tid >> 2, qq = tid & 3; const GAS bf16* vr = P + (size_t)(tok0 + t) * PACT_W + P_GV + qq * 64;
#pragma unroll
            for (int j = 0; j < 8; ++j) xv[j] = *(const GAS v4u*)(vr + 8 * j); }
        __syncthreads();
        {
            const int t = tid >> 2, qq = tid & 3; float s = 0.f, s2 = 0.f;
#pragma unroll
            for (int j = 0; j < 8; ++j)
#pragma unroll
                for (int e = 0; e < 4; ++e) { const float lo = bflo(xv[j][e]), hi = bfhi(xv[j][e]); s += lo + hi; s2 += lo * lo + hi * hi; }
            s = quad_sum(s); s2 = quad_sum(s2);
            const float mean = s * (1.0f / DB), rstd = __builtin_amdgcn_rsqf(fmaxf(s2 * (1.0f / DB) - mean * mean, 0.f) + LN_EPS);
            LAS unsigned short* Vt = (LAS unsigned short*)T + (qq * 64) * VT_STR + t;
#pragma unroll
            for (int j = 0; j < 8; ++j)
#pragma unroll
                for (int e = 0; e < 4; ++e) { Vt[(8 * j + 2 * e) * VT_STR] = (unsigned short)f2bf((bflo(xv[j][e]) - mean) * rstd); Vt[(8 * j + 2 * e + 1) * VT_STR] = (unsigned short)f2bf((bfhi(xv[j][e]) - mean) * rstd); }
        }
        const int fr = lane & 15, fq = lane >> 4, trow = 16 * wave + fr, nks = (16 * wave + 15) / 32 + 1;
        bf16x8 wf[4][4];
#pragma unroll
        for (int h = 0; h < 4; ++h)
#pragma unroll
            for (int ks = 0; ks < 4; ++ks) { wf[h][ks] = (bf16x8){0, 0, 0, 0, 0, 0, 0, 0}; if (ks < nks) wf[h][ks] = *(const GAS bf16x8*)(Wm + ((size_t)(h * CHUNK + trow) * CHUNK + 32 * ks + 8 * fq)); }
        __syncthreads();
        {
            const LAS unsigned short* Vt = (const LAS unsigned short*)T;
            const size_t tok = (size_t)(tok0 + trow);
#pragma unroll
            for (int h = 0; h < 4; ++h) {
                f32x4 acc[4];
#pragma unroll
                for (int nt = 0; nt < 4; ++nt) acc[nt] = (f32x4){0.f, 0.f, 0.f, 0.f};
#pragma unroll
                for (int ks = 0; ks < 4; ++ks) if (ks < nks) {
#pragma unroll
                    for (int nt = 0; nt < 4; ++nt) { const LAS unsigned short* vp = Vt + (h * 64 + nt * 16 + fr) * VT_STR + 32 * ks + 8 * fq;
                        const s16x4 v0 = *(const LAS s16x4*)vp, v1 = *(const LAS s16x4*)(vp + 4);
                        const bf16x8 vf = __builtin_shufflevector(v0, v1, 0, 1, 2, 3, 4, 5, 6, 7);
                        acc[nt] = __builtin_amdgcn_mfma_f32_16x16x32_bf16(vf, wf[h][ks], acc[nt], 0, 0, 0); }
                }
                const float bsv = bs[h * CHUNK + trow], rsw = RSW[h * CHUNK + trow];
#pragma unroll
                for (int nt = 0; nt < 4; ++nt) { const int d0 = h * 64 + nt * 16 + 4 * fq;
                    const v2u gu = *(const GAS v2u*)(P + tok * PACT_W + P_GU + d0);
                    const f32x4 gg = *(const f32x4*)(lvg + d0), bb = *(const f32x4*)(lvb + d0);
                    const float o0 = bflo(gu.x) * (gg[0] * acc[nt][0] + bb[0] * rsw + bsv), o1 = bfhi(gu.x) * (gg[1] * acc[nt][1] + bb[1] * rsw + bsv);
                    const float o2 = bflo(gu.y) * (gg[2] * acc[nt][2] + bb[2] * rsw + bsv), o3 = bfhi(gu.y) * (gg[3] * acc[nt][3] + bb[3] * rsw + bsv);
                    *(GAS v2u*)(MX + tok * D + MIX_B + d0) = (v2u){pk2(o0, o1), pk2(o2, o3)}; }
            }
        }
        __syncthreads();
    }
}

__global__ void __launch_bounds__(NWAVES * 64, 2) hybrid_fwd(Args args) {
    extern __shared__ __attribute__((aligned(16))) unsigned char lds[];
    if (args.ph_hi > N_PHASES) cg::this_grid().sync();
    Frame F;
    F.lds = (LAS unsigned char*)lds;
    F.MISC = (volatile LAS unsigned*)(F.lds + MISC_OFF);
    F.tid = threadIdx.x; F.lane = F.tid & 63; F.wave = __builtin_amdgcn_readfirstlane(F.tid >> 6);
    F.G = gridDim.x;
    F.ctl = (gu32*)(args.ws + WS_CTL);
    for (int u = F.tid; u < (LDS_BYTES - LDSCTL_OFF) / 4; u += NWAVES * 64) ((LAS unsigned*)(F.lds + LDSCTL_OFF))[u] = 0u;
    __syncthreads();
    const int lo = args.ph_lo, hi = args.ph_hi;
    const bool multi = (hi - lo) > 1;
    XcdBarrier bar; bar.bar = (unsigned*)(F.ctl + CW_BAR); bar.x = 0; bar.st = nullptr;
    if (multi && !MK_CG_SYNC) bar = xcd_barrier_post((unsigned*)(F.ctl + CW_BAR), F.MISC + 8);
#define IN(k) (lo <= (k) && (k) < hi)
#define BOTH(k) (IN(k) && IN((k) + 1))
#define SEAM(k) do { if (BOTH(k)) { if (MK_CG_SYNC) cg::this_grid().sync(); else xcd_barrier(bar); } } while (0)
#define PHASE_PTRS() unsigned char* ws = args.ws; LAUNDER_S(ws); float* rowss = (float*)(ws + WS_ROWSS); unsigned char* wl = ws + WS_W + (size_t)l * W_LAYER; (void)rowss; (void)wl

    if (IN(0)) { for (int rep = 0; rep <= PROBE_PRO; ++rep) p0_prologue(F, args); SEAM(0); }
#pragma unroll 1
    for (int l = 0; l < DEPTH; ++l) {
        const int pb = 1 + 7 * l;
        if (IN(pb + 0)) {
            PHASE_PTRS();
            pg8::Gemm g{(const bf16*)(ws + WS_XB), (const bf16*)(wl + WO_GU1), M, NGU, D}; pg8::StaticOrder S; S.init(M, NGU, F.G, (int)blockIdx.x);
            pg8::EpiSwiGLU E{(bf16*)(ws + WS_HID), rowss + (size_t)(3 * l) * M, FF, (LAS float*)(F.lds + RSTBL_OFF)};
            for (int rep = 0; rep <= PROBE_GU; ++rep) { pg8::gemm_phase<pg8::EpiSwiGLU, pg8::StaticOrder, PG8_ALIGN, PG8_SP2>(F.lds + RING_OFF, g, S, E); }
            for (int rep = 0; rep < PROBE_NULLGU; ++rep) { pg8::EpiNull EN; pg8::gemm_phase<pg8::EpiNull, pg8::StaticOrder, PG8_ALIGN, PG8_SP2>(F.lds + RING_OFF, g, S, EN); }
            SEAM(pb + 0);
        }
        if (IN(pb + 1)) {
            PHASE_PTRS();
            pg8::Gemm g{(const bf16*)(ws + WS_HID), (const bf16*)(wl + WO_D1), M, D, FF}; pg8::StaticOrder S; S.init(M, D, F.G, (int)blockIdx.x);
            pg8::EpiResid E{(bf16*)(ws + WS_XB), rowss + (size_t)(3 * l + 1) * M, 0.5f, 1};
            for (int rep = PROBE_D; rep >= 0; --rep) { E.live = (rep == 0); pg8::gemm_phase<pg8::EpiResid, pg8::StaticOrder, PG8_ALIGN, PG8_SP2>(F.lds + RING_OFF, g, S, E); }
            SEAM(pb + 1);
        }
        if (IN(pb + 2)) {
            PHASE_PTRS();
            pg8::Gemm g{(const bf16*)(ws + WS_XB), (const bf16*)(wl + WO_IN), M, NIN, D}; pg8::StaticOrder S; S.init(M, NIN, F.G, (int)blockIdx.x);
            pg8::EpiIn E{(bf16*)(ws + WS_PACT), rowss + (size_t)(3 * l + 1) * M, (LAS float*)(F.lds + RSTBL_OFF)};
            for (int rep = 0; rep <= PROBE_IN; ++rep) { pg8::gemm_phase<pg8::EpiIn, pg8::StaticOrder, PG8_ALIGN, PG8_SP2>(F.lds + RING_OFF, g, S, E); }
            SEAM(pb + 2);
        }
        if (IN(pb + 3)) { for (int rep = 0; rep <= PROBE_MIX; ++rep) mixer_phase(F, args, l); SEAM(pb + 3); }
        if (IN(pb + 4)) {
            PHASE_PTRS();
            pg8::Gemm g{(const bf16*)(ws + WS_MIX), (const bf16*)(wl + WO_OUT), M, D, D}; pg8::StaticOrder S; S.init(M, D, F.G, (int)blockIdx.x);
            pg8::EpiResid E{(bf16*)(ws + WS_XB), rowss + (size_t)(3 * l + 2) * M, 1.0f, 1};
            for (int rep = PROBE_OUT; rep >= 0; --rep) { E.live = (rep == 0); pg8::gemm_phase<pg8::EpiResid, pg8::StaticOrder, PG8_ALIGN, PG8_SP2>(F.lds + RING_OFF, g, S, E); }
            SEAM(pb + 4);
        }
        if (IN(pb + 5)) {
            PHASE_PTRS();
            pg8::Gemm g{(const bf16*)(ws + WS_XB), (const bf16*)(wl + WO_GU2), M, NGU, D}; pg8::StaticOrder S; S.init(M, NGU, F.G, (int)blockIdx.x);
            pg8::EpiSwiGLU E{(bf16*)(ws + WS_HID), rowss + (size_t)(3 * l + 2) * M, FF, (LAS float*)(F.lds + RSTBL_OFF)};
            for (int rep = 0; rep <= PROBE_GU; ++rep) { pg8::gemm_phase<pg8::EpiSwiGLU, pg8::StaticOrder, PG8_ALIGN, PG8_SP2>(F.lds + RING_OFF, g, S, E); }
            SEAM(pb + 5);
        }
        if (IN(pb + 6)) {
            PHASE_PTRS();
            pg8::Gemm g{(const bf16*)(ws + WS_HID), (const bf16*)(wl + WO_D2), M, D, FF}; pg8::StaticOrder S; S.init(M, D, F.G, (int)blockIdx.x);
            pg8::EpiResid E{(bf16*)(ws + WS_XB), rowss + (size_t)(3 * l + 3) * M, 0.5f, 1};
            for (int rep = PROBE_D; rep >= 0; --rep) { E.live = (rep == 0); pg8::gemm_phase<pg8::EpiResid, pg8::StaticOrder, PG8_ALIGN, PG8_SP2>(F.lds + RING_OFF, g, S, E); }
            SEAM(pb + 6);
        }
    }
    if (IN(15)) { for (int rep = 0; rep <= PROBE_FIN; ++rep) final_phase(F, args); }
#undef IN
#undef BOTH
#undef SEAM
#undef PHASE_PTRS
}

extern "C" void kernel_launch(void* const* d_in, const int* in_sizes, int n_in, void* d_out, int out_size, void* d_ws, size_t ws_size, hipStream_t stream) {
    static int grid = 0;
    if (grid == 0) {
        if (n_in != 22 || in_sizes[0] != M * D || out_size != M * D || ws_size < WS_END) { fprintf(stderr, "kernel_launch: shape/workspace mismatch (n_in %d in0 %d out %d ws %zu)\n", n_in, n_in > 0 ? in_sizes[0] : -1, out_size, ws_size); grid = -1; return; }
        int dev = 0, cus = 0, per_cu = 0;
        if (hipGetDevice(&dev) != hipSuccess || hipDeviceGetAttribute(&cus, hipDeviceAttributeMultiprocessorCount, dev) != hipSuccess) { grid = -1; return; }
        if (hipFuncSetAttribute((const void*)hybrid_fwd, hipFuncAttributeMaxDynamicSharedMemorySize, LDS_BYTES) != hipSuccess) { fprintf(stderr, "kernel_launch: hipFuncSetAttribute failed\n"); grid = -1; return; }
        if (hipOccupancyMaxActiveBlocksPerMultiprocessor(&per_cu, (const void*)hybrid_fwd, NWAVES * 64, LDS_BYTES) != hipSuccess || per_cu < 1) { fprintf(stderr, "kernel_launch: occupancy query says %d blocks per CU\n", per_cu); per_cu = 1; }
        (void)hipGetLastError();
        grid = cus * 1;
    }
    if (grid < 0) return;
    (void)hipMemsetAsync((char*)d_ws + WS_CTL, 0, CTL_ZERO_BYTES, stream);
    Args a{};
    for (int i = 0; i < 22; ++i) a.in[i] = (const float*)d_in[i];
    a.out = (float*)d_out; a.ws = (unsigned char*)d_ws;
#if MK_N_LAUNCHES == 1
    a.ph_lo = 0; a.ph_hi = N_PHASES;
    void* kargs[] = {&a};
    hipError_t e = hipLaunchCooperativeKernel((const void*)hybrid_fwd, dim3(grid), dim3(NWAVES * 64), kargs, LDS_BYTES, stream);
    if (e != hipSuccess) fprintf(stderr, "kernel_launch: cooperative launch failed: %s (grid %d)\n", hipGetErrorString(e), grid);
#else
    for (int p = 0; p < N_PHASES; ++p) { a.ph_lo = p; a.ph_hi = p + 1;
        hipLaunchKernelGGL(hybrid_fwd, dim3(grid), dim3(NWAVES * 64), LDS_BYTES, stream, a); }
#endif
}
```

```cpp
#include <hip/hip_runtime.h>
#include <hip/hip_cooperative_groups.h>
#include <cstdio>
#include <cstdint>
namespace cg = cooperative_groups;

#ifndef MK_N_LAUNCHES
#define MK_N_LAUNCHES 1
#endif
#ifndef MK_CG_SYNC
#define MK_CG_SYNC 0
#endif

#ifndef PROBE_GU
#define PROBE_GU 0
#endif
#ifndef PROBE_NULLGU
#define PROBE_NULLGU 0
#endif
#ifndef PROBE_FIXGU
#define PROBE_FIXGU 0
#endif
#ifndef PROBE_D
#define PROBE_D 0
#endif
#ifndef PROBE_IN
#define PROBE_IN 0
#endif
#ifndef PROBE_OUT
#define PROBE_OUT 0
#endif
#ifndef PROBE_MIX
#define PROBE_MIX 0
#endif
#ifndef PROBE_PRO
#define PROBE_PRO 0
#endif
#ifndef PROBE_FIN
#define PROBE_FIN 0
#endif

constexpr int NWAVES = 8;
constexpr int BATCH = 16, SEQ = 2048, M = BATCH * SEQ, D = 1024, FF = 2816, NGU = 2 * FF, DPROJ = 2432, NIN = 2560, DEPTH = 2;
constexpr int DA = 384, DB = 256, DC = 384, PACT_W = 1664, CHUNK = 128, NCHUNK = M / CHUNK;
constexpr int P_GLU = 0, P_GU = 384, P_GV = 640, P_CX = 896, P_CB = 1280;
constexpr int MIX_A = 0, MIX_B = 384, MIX_C = 640;
constexpr float RMS_EPS = 1e-6f, LN_EPS = 1e-5f;
constexpr int N_PHASES = 16;

namespace pg8 {
#define PG8_LAS __attribute__((address_space(3)))
typedef unsigned short bf16_t;
typedef short bf16x8 __attribute__((ext_vector_type(8)));
typedef float f32x4 __attribute__((ext_vector_type(4)));
typedef unsigned u32x4 __attribute__((ext_vector_type(4)));
constexpr int BM = 256, BK = 64, HALF = 128, HTB = HALF * BK * 2  , STAGE_BYTES = 8 * HTB, NXCD = 8, WGM = 8;

__host__ __device__ __forceinline__ int lds_byte(int r, int c) { const int st = (r >> 4) * 2 + (c >> 5), rr = r & 15, cc = c & 31, ob = rr * 64 + cc * 2; return st * 1024 + (ob ^ (((ob >> 9) & 1) << 5)); }
__host__ __device__ __forceinline__ void stage_rc(int b, int& R, int& C) { const int st = b / 1024, sb = b % 1024, swz = sb ^ (((sb >> 9) & 1) << 5); R = (st >> 1) * 16 + swz / 64; C = (st & 1) * 32 + (swz % 64) / 2; }
__host__ __device__ __forceinline__ int perm32(int rho) { const int n = rho >> 4, i = rho & 15; return 8 * (i >> 2) + 4 * n + (i & 3); }

struct Unit { int pm, pn; };
struct Gemm { const bf16_t* A; const bf16_t* Bt; int M, N, K; };

struct StaticOrder {
    int nM, nN, nwg, G, c;
    __host__ __device__ void init(int M, int N, int G_, int c_) { nM = M / BM; nN = N / BM; nwg = nM * nN; G = G_; c = c_; }
    __host__ __device__ bool next(int i, Unit& u) const {
        const long L = (long)i * G + c; if (L >= nwg) return false;
        int wgid = (int)L; { const int q = nwg / NXCD, r = nwg % NXCD, xcd = wgid % NXCD, off = wgid / NXCD; wgid = (xcd < r ? xcd * (q + 1) : r * (q + 1) + (xcd - r) * q) + off; }
        const int nig = WGM * nN, gid = wgid / nig, fm = gid * WGM, gsz = (nM - fm) < WGM ? (nM - fm) : WGM;
        u.pm = fm + ((wgid % nig) % gsz); u.pn = (wgid % nig) / gsz; return true;
    }
    __device__ __forceinline__ void a_ready(const Unit&) const {}
    __device__ __forceinline__ void done(const Unit&) const {}
};

__device__ __forceinline__ unsigned cvt_pk_bf16(float lo, float hi) { unsigned r; asm volatile("v_cvt_pk_bf16_f32 %0, %1, %2" : "=v"(r) : "v"(lo), "v"(hi)); return r; }
__device__ __forceinline__ float sigmoid_f(float x) { return __builtin_amdgcn_rcpf(1.0f + __builtin_amdgcn_exp2f(-1.4426950408889634f * x)); }
__device__ __forceinline__ float gelu_tanh_f(float x) { const float z = x * (1.5957691216057308f + 0.07135481282817f * x * x); return x * sigmoid_f(z); }
__device__ __forceinline__ u32x4 pack8(const f32x4 a, const f32x4 b) { u32x4 w; w.x = cvt_pk_bf16(a[0], a[1]); w.y = cvt_pk_bf16(a[2], a[3]); w.z = cvt_pk_bf16(b[0], b[1]); w.w = cvt_pk_bf16(b[2], b[3]); return w; }
#define PG8_GAS __attribute__((address_space(1)))
__device__ __forceinline__ f32x4 exp4(const f32x4 t) { f32x4 e; e[0] = __builtin_amdgcn_exp2f(t[0]); e[1] = __builtin_amdgcn_exp2f(t[1]); e[2] = __builtin_amdgcn_exp2f(t[2]); e[3] = __builtin_amdgcn_exp2f(t[3]); return e; }
__device__ __forceinline__ f32x4 rcp4(const f32x4 t) { f32x4 e; e[0] = __builtin_amdgcn_rcpf(t[0]); e[1] = __builtin_amdgcn_rcpf(t[1]); e[2] = __builtin_amdgcn_rcpf(t[2]); e[3] = __builtin_amdgcn_rcpf(t[3]); return e; }
__device__ __forceinline__ f32x4 gelu4(const f32x4 x) { const f32x4 z = x * (x * x * -0.10294324f + -2.3022082f); return x * rcp4(exp4(z) + 1.0f); }
__device__ __forceinline__ float rs_of(float ss) { return __builtin_amdgcn_rsqf(ss * (1.0f / 1024.0f) + 1e-6f); }
__device__ __forceinline__ void load_rs(const float* rowss, int row0, float (&rs)[2][4]) {
    const PG8_GAS float* p = (const PG8_GAS float*)rowss + row0;
#pragma unroll
    for (int ai = 0; ai < 2; ++ai)
#pragma unroll
        for (int m = 0; m < 4; ++m) rs[ai][m] = p[ai * HALF + m * 16];
#pragma unroll
    for (int ai = 0; ai < 2; ++ai)
#pragma unroll
        for (int m = 0; m < 4; ++m) rs[ai][m] = rs_of(rs[ai][m]);
}

__device__ __forceinline__ void dma_rowss(const float* rowss, PG8_LAS float* tbl, int pm, int wid, int lane) {
    if (wid < 4) __builtin_amdgcn_global_load_lds((const unsigned*)(rowss + (size_t)pm * BM + wid * 64 + lane), (PG8_LAS unsigned*)(tbl + wid * 64), 4, 0, 0);
}
__device__ __forceinline__ void load_rs_lds(const PG8_LAS float* tbl, int wr, int fr, float (&rs)[2][4]) {
#pragma unroll
    for (int ai = 0; ai < 2; ++ai)
#pragma unroll
        for (int m = 0; m < 4; ++m) rs[ai][m] = rs_of(tbl[ai * HALF + wr * 64 + m * 16 + fr]);
}
struct EpiSwiGLU {
    static constexpr bool PERM = true, AFTER_DRAIN = false;
    bf16_t* H; const float* rowss; int ldh; PG8_LAS float* tbl;
    __device__ __forceinline__ void prefetch(const Unit& u, int wid, int lane) const { dma_rowss(rowss, tbl, u.pm, wid, lane); }
    __device__ __forceinline__ void operator()(const f32x4 (&acc)[2][2][4][2], const Unit& u, int wr, int wc, int fr, int fq) const {
        const int row0 = u.pm * BM + wr * 64 + fr, col0 = u.pn * HALF + wc * 32 + 8 * fq;
        float rsv[2][4]; load_rs_lds(tbl, wr, fr, rsv);
        PG8_GAS bf16_t* hp = (PG8_GAS bf16_t*)H + (size_t)row0 * ldh + col0;
#pragma unroll
        for (int ai = 0; ai < 2; ++ai)
#pragma unroll
            for (int m = 0; m < 4; ++m) { const float rs = rsv[ai][m], c1 = -1.4426950408889634f * rs, rs2 = rs * rs;
                f32x4 o[2];
#pragma unroll
                for (int n = 0; n < 2; ++n) { const f32x4 g = acc[ai][0][m][n], t = g * c1; f32x4 e;
#pragma unroll
                    for (int j = 0; j < 4; ++j) e[j] = __builtin_amdgcn_exp2f(t[j]);
                    const f32x4 den = e + 1.0f; f32x4 r;
#pragma unroll
                    for (int j = 0; j < 4; ++j) r[j] = __builtin_amdgcn_rcpf(den[j]);
                    o[n] = (g * acc[ai][1][m][n]) * (r * rs2); }
                *(PG8_GAS u32x4*)(hp + (size_t)(ai * HALF + m * 16) * ldh) = pack8(o[0], o[1]); }
    }
};
__device__ __forceinline__ float bf_lo(unsigned w) { return __uint_as_float(w << 16); }
__device__ __forceinline__ float bf_hi(unsigned w) { return __uint_as_float(w & 0xffff0000u); }
struct EpiResid {
    static constexpr bool PERM = true, AFTER_DRAIN = false;
    bf16_t* xb; float* rowss; float scale; int live;
    __device__ __forceinline__ void prefetch(const Unit&, int, int) const {}
    __device__ __forceinline__ void operator()(const f32x4 (&acc)[2][2][4][2], const Unit& u, int wr, int wc, int fr, int fq) const {
        const int row0 = u.pm * BM + wr * 64 + fr, col0 = u.pn * BM + wc * 32 + 8 * fq;
        PG8_GAS bf16_t* xp = (PG8_GAS bf16_t*)xb + (size_t)row0 * 1024 + col0; PG8_GAS float* sp = (PG8_GAS float*)rowss + row0;
#pragma unroll
        for (int ai = 0; ai < 2; ++ai) {
            u32x4 x[4][2];
#pragma unroll
            for (int m = 0; m < 4; ++m)
#pragma unroll
                for (int bj = 0; bj < 2; ++bj) x[m][bj] = *(const PG8_GAS u32x4*)(xp + (size_t)(ai * HALF + m * 16) * 1024 + bj * HALF);
#pragma unroll
            for (int m = 0; m < 4; ++m) { float ss = 0.f;
#pragma unroll
                for (int bj = 0; bj < 2; ++bj) { const float sc = live ? scale : 0.f; const f32x4 a0 = acc[ai][bj][m][0] * sc, a1 = acc[ai][bj][m][1] * sc; const u32x4 xv = x[m][bj]; f32x4 v0, v1;
                    v0[0] = bf_lo(xv[0]) + a0[0]; v0[1] = bf_hi(xv[0]) + a0[1]; v0[2] = bf_lo(xv[1]) + a0[2]; v0[3] = bf_hi(xv[1]) + a0[3];
                    v1[0] = bf_lo(xv[2]) + a1[0]; v1[1] = bf_hi(xv[2]) + a1[1]; v1[2] = bf_lo(xv[3]) + a1[2]; v1[3] = bf_hi(xv[3]) + a1[3];
                    *(PG8_GAS u32x4*)(xp + (size_t)(ai * HALF + m * 16) * 1024 + bj * HALF) = pack8(v0, v1);
                    ss += (v0[0] * v0[0] + v0[1] * v0[1]) + (v0[2] * v0[2] + v0[3] * v0[3]) + (v1[0] * v1[0] + v1[1] * v1[1]) + (v1[2] * v1[2] + v1[3] * v1[3]); }
                ss += __shfl_xor(ss, 16); ss += __shfl_xor(ss, 32);
                if (fq == 0 && live) (void)__builtin_amdgcn_global_atomic_fadd_f32(sp + ai * HALF + m * 16, ss); }
        }
    }
};
struct EpiIn {
    static constexpr bool PERM = true, AFTER_DRAIN = false;
    bf16_t* P; const float* rowss; PG8_LAS float* tbl;
    __device__ __forceinline__ void prefetch(const Unit& u, int wid, int lane) const { dma_rowss(rowss, tbl, u.pm, wid, lane); }
    __device__ __forceinline__ void operator()(const f32x4 (&acc)[2][2][4][2], const Unit& u, int wr, int wc, int fr, int fq) const {
        const int row0 = u.pm * BM + wr * 64 + fr, cw = wc * 32 + 8 * fq, pn = u.pn;
        float rsv[2][4]; load_rs_lds(tbl, wr, fr, rsv);
        PG8_GAS bf16_t* pp = (PG8_GAS bf16_t*)P + (size_t)row0 * 1664 + cw;
#pragma unroll
        for (int ai = 0; ai < 2; ++ai)
#pragma unroll
            for (int m = 0; m < 4; ++m) { const float rs = rsv[ai][m];
                PG8_GAS bf16_t* rp = pp + (size_t)(ai * HALF + m * 16) * 1664;
                const f32x4 A0 = acc[ai][0][m][0], A1 = acc[ai][0][m][1], B0 = acc[ai][1][m][0], B1 = acc[ai][1][m][1];
                if (pn < 3) { const float c1 = -1.4426950408889634f * rs;
                    *(PG8_GAS u32x4*)(rp + 0 + pn * HALF) = pack8(A0 * (rcp4(exp4(B0 * c1) + 1.0f) * rs), A1 * (rcp4(exp4(B1 * c1) + 1.0f) * rs));
                } else if (pn < 5) {
                    *(PG8_GAS u32x4*)(rp + 384 + (pn - 3) * BM) = pack8(gelu4(A0 * rs), gelu4(A1 * rs)); *(PG8_GAS u32x4*)(rp + 384 + (pn - 3) * BM + HALF) = pack8(gelu4(B0 * rs), gelu4(B1 * rs));
                } else if (pn < 8) { const float rs2 = rs * rs;
                    *(PG8_GAS u32x4*)(rp + 896 + (pn - 5) * HALF) = pack8(A0 * B0 * rs2, A1 * B1 * rs2);
                } else if (pn == 8) {
                    *(PG8_GAS u32x4*)(rp + 1280) = pack8(A0 * rs, A1 * rs); *(PG8_GAS u32x4*)(rp + 1280 + HALF) = pack8(B0 * rs, B1 * rs);
                } else {
                    *(PG8_GAS u32x4*)(rp + 1280 + BM) = pack8(A0 * rs, A1 * rs);
                } }
    }
};

struct EpiNull {
    static constexpr bool PERM = true, AFTER_DRAIN = false;
    __device__ __forceinline__ void prefetch(const Unit&, int, int) const {}
    __device__ __forceinline__ void operator()(const f32x4 (&acc)[2][2][4][2], const Unit& u, int wr, int wc, int fr, int fq) const {
#pragma unroll
        for (int ai = 0; ai < 2; ++ai)
#pragma unroll
            for (int bj = 0; bj < 2; ++bj)
#pragma unroll
                for (int m = 0; m < 4; ++m)
#pragma unroll
                    for (int n = 0; n < 2; ++n) asm volatile("" :: "v"(acc[ai][bj][m][n]));
    }
};

template <class Epi, class Sched, bool ALIGN_EPI = false, bool SP2 = false>
__device__ __forceinline__ void gemm_phase(PG8_LAS unsigned char* lds, const Gemm g, const Sched& S, const Epi& E) {
    int tid_ = threadIdx.x; asm volatile("" : "+v"(tid_)); const int tid = tid_, wid = __builtin_amdgcn_readfirstlane(tid >> 6), lane = tid & 63, wr = wid >> 2, wc = wid & 3, fr = lane & 15, fq = lane >> 4;
    const int K = g.K, nt = K / BK;
    unsigned voffA[2], voffB[2];
#pragma unroll
    for (int i = 0; i < 2; ++i) { int R, C; stage_rc(tid * 16 + i * 8192, R, C); const int Rb = Epi::PERM ? ((R & ~31) + perm32(R & 31)) : R;
        voffA[i] = (unsigned)(R * K + C) * 2u; voffB[i] = (unsigned)(Rb * K + C) * 2u; }
    const size_t kstep = (size_t)(BK * 2);
    const size_t hstep = (size_t)HALF * K * 2;
    const size_t tstep = 2 * hstep;
    const unsigned ldsw = (unsigned)wid * 1024u;
    const int aoff = lds_byte(wr * 64 + fr, fq * 8), boff = lds_byte(wc * 32 + fr, fq * 8);
#define PG8_SA(b, h) (((b) * 2 + (h)) * HTB)
#define PG8_SB(b, h) ((4 + (b) * 2 + (h)) * HTB)
#define PG8_STAGE(bufoff, gbase, voff) do { _Pragma("unroll") for (int _i = 0; _i < 2; ++_i) \
        __builtin_amdgcn_global_load_lds((const unsigned*)((const char*)(gbase) + (voff)[_i]), (PG8_LAS unsigned*)(lds + (bufoff) + ldsw + _i * 8192), 16, 0, 0); } while (0)
#define PG8_LDA(dst, b, h) do { _Pragma("unroll") for (int m = 0; m < 4; ++m) _Pragma("unroll") for (int k = 0; k < 2; ++k) dst[m][k] = *(const PG8_LAS bf16x8*)(lds + PG8_SA(b, h) + aoff + m * 2048 + k * 1024); } while (0)
#define PG8_LDB(dst, b, h) do { _Pragma("unroll") for (int n = 0; n < 2; ++n) _Pragma("unroll") for (int k = 0; k < 2; ++k) dst[n][k] = *(const PG8_LAS bf16x8*)(lds + PG8_SB(b, h) + boff + n * 2048 + k * 1024); } while (0)
#define PG8_MMA(ai, bj, At, Bt) do { __builtin_amdgcn_s_setprio(1); _Pragma("unroll") for (int m = 0; m < 4; ++m) _Pragma("unroll") for (int n = 0; n < 2; ++n) _Pragma("unroll") for (int k = 0; k < 2; ++k) \
        acc[ai][bj][m][n] = __builtin_amdgcn_mfma_f32_16x16x32_bf16(Bt[n][k], At[m][k], acc[ai][bj][m][n], 0, 0, 0); __builtin_amdgcn_s_setprio(0); } while (0)
#define PG8_WAIT_V(n) asm volatile("s_waitcnt vmcnt(" #n ")" ::: "memory")
#define PG8_WAIT_L(n) asm volatile("s_waitcnt lgkmcnt(" #n ")" ::: "memory")
#define PG8_BAR __builtin_amdgcn_s_barrier()
#define PG8_SCHED __builtin_amdgcn_sched_barrier(0)
    Unit cur, nxt; int ui = 0;
    if (!S.next(0, cur)) return;
    f32x4 acc[2][2][4][2];
#pragma unroll
    for (int a = 0; a < 2; ++a)
#pragma unroll
        for (int b = 0; b < 2; ++b)
#pragma unroll
            for (int m = 0; m < 4; ++m)
#pragma unroll
                for (int n = 0; n < 2; ++n) acc[a][b][m][n] = (f32x4){0.f, 0.f, 0.f, 0.f};
    bf16x8 At[4][2], B0[2][2], B1[2][2];
    const char* cA = (const char*)g.A + (size_t)cur.pm * tstep; const char* cB = (const char*)g.Bt + (size_t)cur.pn * tstep;
    S.a_ready(cur);
    if constexpr (SP2) {
        PG8_STAGE(PG8_SB(0, 0), cB, voffB); PG8_STAGE(PG8_SB(0, 1), cB + hstep, voffB); PG8_STAGE(PG8_SA(0, 0), cA, voffA); PG8_STAGE(PG8_SA(0, 1), cA + hstep, voffA);
        if (wr == 1) PG8_BAR;
        PG8_WAIT_V(2); PG8_BAR;
        PG8_STAGE(PG8_SB(1, 0), cB + kstep, voffB); PG8_STAGE(PG8_SA(1, 0), cA + kstep, voffA); PG8_STAGE(PG8_SB(1, 1), cB + hstep + kstep, voffB);
        PG8_WAIT_V(6); PG8_BAR;
    } else {
        PG8_STAGE(PG8_SB(0, 0), cB, voffB); PG8_STAGE(PG8_SA(0, 0), cA, voffA); PG8_STAGE(PG8_SB(0, 1), cB + hstep, voffB); PG8_STAGE(PG8_SA(0, 1), cA + hstep, voffA);
        if (wr == 1) PG8_BAR;
        PG8_WAIT_V(4); PG8_BAR;
        PG8_STAGE(PG8_SB(1, 0), cB + kstep, voffB); PG8_STAGE(PG8_SA(1, 0), cA + kstep, voffA); PG8_STAGE(PG8_SB(1, 1), cB + hstep + kstep, voffB);
        PG8_WAIT_V(6); PG8_BAR;
    }
    for (;;) {
        const bool has_next = S.next(ui + 1, nxt);
        const char* nA = has_next ? (const char*)g.A + (size_t)nxt.pm * tstep : cA; const char* nB = has_next ? (const char*)g.Bt + (size_t)nxt.pn * tstep : cB;
        for (int t = 0; t < nt; t += 2) {
            const bool last = (t == nt - 2);
            const char* a1 = cA + (size_t)(t + 1) * kstep;
            const char* a2 = last ? nA : cA + (size_t)(t + 2) * kstep; const char* b2 = last ? nB : cB + (size_t)(t + 2) * kstep;
            const char* a3 = a2 + kstep; const char* b3 = b2 + kstep;
            if (last && has_next) S.a_ready(nxt);
            if (last) E.prefetch(cur, wid, lane);
            if constexpr (SP2) {
            PG8_LDB(B0, 0, 0); PG8_LDB(B1, 0, 1); PG8_SCHED; PG8_LDA(At, 0, 0); PG8_STAGE(PG8_SA(1, 1), a1 + hstep, voffA);
            PG8_WAIT_V(8); PG8_WAIT_L(0); PG8_BAR; PG8_MMA(0, 0, At, B0); PG8_MMA(0, 1, At, B1); PG8_BAR; PG8_SCHED;
            PG8_LDA(At, 0, 1); PG8_STAGE(PG8_SB(0, 0), b2, voffB); PG8_STAGE(PG8_SB(0, 1), b2 + hstep, voffB); PG8_STAGE(PG8_SA(0, 0), a2, voffA);
            PG8_WAIT_V(8); PG8_WAIT_L(0); PG8_BAR; PG8_MMA(1, 0, At, B0); PG8_MMA(1, 1, At, B1); PG8_BAR; PG8_SCHED;
            PG8_LDB(B0, 1, 0); PG8_LDB(B1, 1, 1); PG8_SCHED; PG8_LDA(At, 1, 0); PG8_STAGE(PG8_SA(0, 1), a2 + hstep, voffA);
            PG8_WAIT_V(8); PG8_WAIT_L(0); PG8_BAR; PG8_MMA(0, 0, At, B0); PG8_MMA(0, 1, At, B1); PG8_BAR; PG8_SCHED;
            PG8_LDA(At, 1, 1); PG8_STAGE(PG8_SB(1, 0), b3, voffB); PG8_STAGE(PG8_SB(1, 1), b3 + hstep, voffB); PG8_STAGE(PG8_SA(1, 0), a3, voffA);
            PG8_WAIT_V(8); PG8_WAIT_L(0); PG8_BAR; PG8_MMA(1, 0, At, B0); PG8_MMA(1, 1, At, B1); PG8_BAR; PG8_SCHED;
            } else {
            PG8_LDB(B0, 0, 0); PG8_SCHED; PG8_LDA(At, 0, 0); PG8_STAGE(PG8_SA(1, 1), a1 + hstep, voffA);
            PG8_WAIT_L(8); PG8_BAR; PG8_WAIT_L(0); PG8_MMA(0, 0, At, B0); PG8_BAR; PG8_SCHED;
            PG8_LDB(B1, 0, 1); PG8_STAGE(PG8_SB(0, 0), b2, voffB);
            PG8_BAR; PG8_WAIT_L(0); PG8_MMA(0, 1, At, B1); PG8_BAR;
            PG8_LDA(At, 0, 1); PG8_STAGE(PG8_SA(0, 0), a2, voffA);
            PG8_BAR; PG8_WAIT_L(0); PG8_MMA(1, 0, At, B0); PG8_BAR; PG8_SCHED;
            PG8_STAGE(PG8_SB(0, 1), b2 + hstep, voffB);
            PG8_WAIT_V(6); PG8_BAR; PG8_MMA(1, 1, At, B1); PG8_BAR;
            PG8_LDB(B0, 1, 0); PG8_SCHED; PG8_LDA(At, 1, 0); PG8_STAGE(PG8_SA(0, 1), a2 + hstep, voffA);
            PG8_WAIT_L(8); PG8_BAR; PG8_WAIT_L(0); PG8_MMA(0, 0, At, B0); PG8_BAR; PG8_SCHED;
            PG8_LDB(B1, 1, 1); PG8_STAGE(PG8_SB(1, 0), b3, voffB);
            PG8_BAR; PG8_WAIT_L(0); PG8_MMA(0, 1, At, B1); PG8_BAR;
            PG8_LDA(At, 1, 1); PG8_STAGE(PG8_SA(1, 0), a3, voffA);
            PG8_BAR; PG8_WAIT_L(0); PG8_MMA(1, 0, At, B0); PG8_BAR; PG8_SCHED;
            PG8_STAGE(PG8_SB(1, 1), b3 + hstep, voffB);
            PG8_WAIT_V(6); PG8_BAR; PG8_MMA(1, 1, At, B1); PG8_BAR;
            }
        }
        if constexpr (ALIGN_EPI) { if (wr == 0) PG8_BAR; }
        if constexpr (!Epi::AFTER_DRAIN) { E(acc, cur, wr, wc, fr, fq); S.done(cur); }
        if (!has_next) break;
#pragma unroll
        for (int a = 0; a < 2; ++a)
#pragma unroll
            for (int b = 0; b < 2; ++b)
#pragma unroll
                for (int m = 0; m < 4; ++m)
#pragma unroll
                    for (int n = 0; n < 2; ++n) acc[a][b][m][n] = (f32x4){0.f, 0.f, 0.f, 0.f};
        cur = nxt; cA = nA; cB = nB; ++ui;
        if constexpr (ALIGN_EPI) { if (wr == 1) PG8_BAR; }
    }
    PG8_WAIT_V(0);
    if constexpr (!ALIGN_EPI) { if (wr == 0) PG8_BAR; }
    PG8_BAR;
    if constexpr (Epi::AFTER_DRAIN) { E.fused(acc, cur, wr, wc, fr, fq, lds, wid, lane); S.done(cur); }
#undef PG8_SA
#undef PG8_SB
#undef PG8_STAGE
#undef PG8_LDA
#undef PG8_LDB
#undef PG8_MMA
#undef PG8_WAIT_V
#undef PG8_WAIT_L
#undef PG8_BAR
#undef PG8_SCHED
}
}

#ifndef PG8_SP2
#define PG8_SP2 true
#endif
#ifndef PG8_ALIGN
#define PG8_ALIGN true
#endif

constexpr size_t MiB = 1u << 20;
constexpr size_t WS_CTL = 0, CTL_ZERO_BYTES = 64 * 1024;
constexpr size_t WS_ROWSS = 1 * MiB;
constexpr size_t WS_W = 2 * MiB, W_LAYER = 41 * MiB;
constexpr size_t WO_GU1 = 0, WO_D1 = 11 * MiB, WO_IN = 17 * MiB, WO_OUT = 22 * MiB, WO_GU2 = 24 * MiB, WO_D2 = 35 * MiB, WO_S = 40 * MiB + 512 * 1024, WO_RSW = WO_S + 4 * 128 * 128 * 2;
constexpr size_t WS_XB = 84 * MiB;
constexpr size_t WS_HID = 148 * MiB;
constexpr size_t WS_PACT = 148 * MiB, WS_MIX = 252 * MiB;
constexpr size_t WS_END = 324 * MiB;
static_assert(WO_D1 >= (size_t)NGU * D * 2 && WO_IN - WO_D1 >= (size_t)D * FF * 2 && WO_OUT - WO_IN >= (size_t)NIN * D * 2 && WO_S - WO_D2 >= (size_t)D * FF * 2 && WO_RSW + 4 * 128 * 4 <= W_LAYER, "weight map");
static_assert(WS_W + DEPTH * W_LAYER <= WS_XB && WS_XB + (size_t)M * D * 2 <= WS_HID && WS_HID + (size_t)M * FF * 2 <= WS_END && WS_PACT + (size_t)M * PACT_W * 2 <= WS_MIX && WS_MIX + (size_t)M * D * 2 <= WS_END, "d_ws map");
constexpr int CW_BAR = 1024;

constexpr int RING_OFF = 0, RING_BYTES = 131072;
constexpr int LDSCTL_OFF = RING_BYTES, MISC_OFF = LDSCTL_OFF + 320;
constexpr int RSTBL_OFF = RING_BYTES + 2048;
constexpr int LDS_BYTES = 163840;
static_assert(MISC_OFF + 128 <= LDS_BYTES, "LDS map");

#define GAS __attribute__((address_space(1)))
#define LAS __attribute__((address_space(3)))
typedef unsigned short bf16;
typedef unsigned v4u __attribute__((ext_vector_type(4)));
typedef unsigned v2u __attribute__((ext_vector_type(2)));
typedef float f32x4 __attribute__((ext_vector_type(4)));
typedef short bf16x8 __attribute__((ext_vector_type(8)));
typedef short s16x4 __attribute__((ext_vector_type(4)));
typedef GAS unsigned gu32;
#define RLX_AGENT __ATOMIC_RELAXED, __HIP_MEMORY_SCOPE_AGENT
#define LDS_WAIT() asm volatile("s_waitcnt lgkmcnt(0)" ::: "memory")
#define VM_WAIT() asm volatile("s_waitcnt vmcnt(0)" ::: "memory")
typedef float cvt_f32x2 __attribute__((ext_vector_type(2)));
typedef __bf16 cvt_bf16x2 __attribute__((ext_vector_type(2)));
__device__ __forceinline__ unsigned pk2(float lo, float hi) { return __builtin_bit_cast(unsigned, __builtin_convertvector((cvt_f32x2){lo, hi}, cvt_bf16x2)); }
__device__ __forceinline__ unsigned f2bf(float f) { return pk2(f, 0.f) & 0xffffu; }
__device__ __forceinline__ float bflo(unsigned w) { return __uint_as_float(w << 16); }
__device__ __forceinline__ float bfhi(unsigned w) { return __uint_as_float(w & 0xffff0000u); }
__device__ __forceinline__ float sigm(float x) { return __builtin_amdgcn_rcpf(1.0f + __builtin_amdgcn_exp2f(-1.4426950408889634f * x)); }

#define XB_TMO      128
#define XB_XCNT(j)  (256  + 64 * (j))
#define XB_XSUB(j)  (1280 + 64 * (j))
#define XB_XGEN(j)  (2304 + 64 * (j))
#define XB_TOP      3328
#define XB_TOPGEN   3392
#define XCD_BAR_WORDS 3456
#define XB_SPIN_CAP (1u << 18)

__device__ __forceinline__ unsigned xb_ld(GAS unsigned* p)          { return __hip_atomic_load(p, __ATOMIC_RELAXED, __HIP_MEMORY_SCOPE_AGENT); }
__device__ __forceinline__ unsigned xb_add(GAS unsigned* p, unsigned v) { return __hip_atomic_fetch_add(p, v, __ATOMIC_RELAXED, __HIP_MEMORY_SCOPE_AGENT); }
__device__ __forceinline__ unsigned xb_xcc_id() { return (unsigned)__builtin_amdgcn_s_getreg((3 << 11) | 20) & 0xFu; }
#define XB_SPIN(cond, bar) do { unsigned _sp = 0; while (cond) { __builtin_amdgcn_s_sleep(1); \
    if ((++_sp & 255u) == 0u) { if (xb_ld(&(bar)[XB_TMO])) break; if (_sp > XB_SPIN_CAP) { atomicAdd((unsigned*)&(bar)[XB_TMO], 1u); break; } } } } while (0)

struct XcdBarrier {
    unsigned* bar; unsigned x;
    volatile LAS unsigned* st;
};

__device__ __forceinline__ XcdBarrier xcd_barrier_post(unsigned* bar, volatile LAS unsigned* st) {
    XcdBarrier b; b.bar = bar; b.x = xb_xcc_id(); b.st = st;
    if (threadIdx.x == 0) (void)xb_add((GAS unsigned*)&bar[XB_XCNT(b.x)], 1u);
    return b;
}
__device__ __forceinline__ void xcd_barrier_complete(GAS unsigned* bar, unsigned x, unsigned& nloc, unsigned& nx) {
    const unsigned G = gridDim.x * gridDim.y * gridDim.z;
    unsigned sum, cnt, mine, sp = 0u;
    for (;;) {
        sum = 0u; cnt = 0u; mine = 0u;
#pragma unroll
        for (unsigned j = 0; j < 16; ++j) { const unsigned c = xb_ld(&bar[XB_XCNT(j)]); sum += c; cnt += (c > 0u) ? 1u : 0u; mine = (j == x) ? c : mine; }
        if (sum == G) break;
        __builtin_amdgcn_s_sleep(1);
        if ((++sp & 255u) == 0u) { if (xb_ld(&bar[XB_TMO])) break; if (sp > XB_SPIN_CAP) { atomicAdd((unsigned*)&bar[XB_TMO], 1u); break; } }
    }
    nloc = mine > 0u ? mine : 1u; nx = cnt > 0u ? cnt : 1u;
}

__device__ __forceinline__ void xcd_barrier(const XcdBarrier& b) {
    asm volatile("s_waitcnt vmcnt(0)" ::: "memory");
    __syncthreads();
    if (threadIdx.x == 0) {
        unsigned long long bi_ = (unsigned long long)b.bar; asm volatile("" : "+s"(bi_));
        GAS unsigned* bar = (GAS unsigned*)bi_;
        __builtin_amdgcn_s_waitcnt(0);
        unsigned nloc = b.st[0], nx = b.st[1];
        if (nloc == 0u) { xcd_barrier_complete(bar, b.x, nloc, nx); b.st[0] = nloc; b.st[1] = nx; }
        const unsigned old = xb_add(&bar[XB_XSUB(b.x)], 1u);
        const unsigned gen = old / nloc;
        if (old + 1u == (gen + 1u) * nloc) {
            __builtin_amdgcn_fence(__ATOMIC_RELEASE, "agent");
            asm volatile("s_waitcnt vmcnt(0)" ::: "memory");
            const unsigned og = xb_add(&bar[XB_TOP], 1u);
            const unsigned tg = og / nx;
            if (og + 1u == (tg + 1u) * nx) xb_add(&bar[XB_TOPGEN], 1u);
            else XB_SPIN(xb_ld(&bar[XB_TOPGEN]) == tg, bar);
            __builtin_amdgcn_fence(__ATOMIC_ACQUIRE, "agent");
            xb_add(&bar[XB_XGEN(b.x)], 1u);
            asm volatile("s_waitcnt vmcnt(0)" ::: "memory");
        } else {
            XB_SPIN(xb_ld(&bar[XB_XGEN(b.x)]) == gen, bar);
            __builtin_amdgcn_fence(__ATOMIC_ACQUIRE, "agent");
            asm volatile("s_waitcnt vmcnt(0)" ::: "memory");
        }
    }
    __syncthreads();
}

struct Frame {
    LAS unsigned char* lds;
    volatile LAS unsigned* MISC;
    gu32* ctl;
    int tid, lane, wave, G;
};
struct Args { const float* in[22]; float* out; unsigned char* ws; int ph_lo, ph_hi; };
#define LAUNDER_S(p) asm volatile("" : "+s"(p))
__device__ __forceinline__ float wave_sum(float v) {
#pragma unroll
    for (int o = 1; o < 64; o <<= 1) v += __shfl_xor(v, o);
    return v;
}
enum { I_X = 0, I_N1, I_G1, I_U1, I_D1, I_NM, I_WIN, I_CAW, I_CAB, I_LAG, I_LAB, I_LVG, I_LVB, I_WS, I_BS, I_CCW, I_WOUT, I_N2, I_G2, I_U2, I_D2, I_NF };

__device__ __forceinline__ void p0_transpose_item(const float* W, int N, int K, bf16* WT, int dest_row0, const float* gain, LAS float* scr, int k0, int n0, int lane) {
    const GAS float* wp = (const GAS float*)W + (size_t)(k0 + (lane >> 5)) * N + n0 + (lane & 31);
    float v[32];
#pragma unroll
    for (int i = 0; i < 32; ++i) { v[i] = *wp; wp += 2 * N; }
    const int c = lane & 7;
    f32x4 g0 = (f32x4){1.f, 1.f, 1.f, 1.f}, g1 = g0;
    if (gain) { g0 = *(const GAS f32x4*)(gain + k0 + 8 * c); g1 = *(const GAS f32x4*)(gain + k0 + 8 * c + 4); }
#pragma unroll
    for (int i = 0; i < 32; ++i) scr[(2 * i + (lane >> 5)) * 33 + (lane & 31)] = v[i];
    LDS_WAIT(); asm volatile("" ::: "memory");
#pragma unroll
    for (int j = 0; j < 4; ++j) { const int n = (lane >> 3) + 8 * j; const LAS float* s = scr + (8 * c) * 33 + n;
        v4u o; o.x = pk2(s[0 * 33] * g0[0], s[1 * 33] * g0[1]); o.y = pk2(s[2 * 33] * g0[2], s[3 * 33] * g0[3]); o.z = pk2(s[4 * 33] * g1[0], s[5 * 33] * g1[1]); o.w = pk2(s[6 * 33] * g1[2], s[7 * 33] * g1[3]);
        *(GAS v4u*)(WT + (size_t)(dest_row0 + n) * K + k0 + 8 * c) = o; }
    LDS_WAIT(); asm volatile("" ::: "memory");
}
__device__ __forceinline__ int map_gu(int n0, int up) { return (n0 >> 7) * 256 + (n0 & 127) + (up ? 128 : 0); }
__device__ __forceinline__ int map_in(int n) {
    if (n < 384) return (n >> 7) * 256 + (n & 127);
    if (n < 768) { const int r = n - 384; return (r >> 7) * 256 + 128 + (r & 127); }
    if (n < 1280) return n;
    if (n < 1664) return 2048 + (n - 1280);
    if (n < 2048) { const int r = n - 1664; return 1280 + (r >> 7) * 256 + (r & 127); }
    { const int r = n - 2048; return 1280 + (r >> 7) * 256 + 128 + (r & 127); }
}
__device__ __forceinline__ void p0_prologue(Frame& F, const Args& A) {
    unsigned char* ws = A.ws; LAUNDER_S(ws);
    LAS float* scr = (LAS float*)(F.lds + RING_OFF + F.wave * 16384);
    const int gw = blockIdx.x * NWAVES + F.wave, NGW = F.G * NWAVES, lane = F.lane;
    constexpr int I_GU = (D / 64) * (FF / 32), I_DN = (FF / 64) * (D / 32), I_IN = (D / 64) * (DPROJ / 32), I_OUT = (D / 64) * (D / 32);
    constexpr int PER_LAYER = 4 * I_GU + 2 * I_DN + I_IN + I_OUT;
    for (int it = gw; it < DEPTH * PER_LAYER; it += NGW) {
        const int l = it / PER_LAYER; int r = it % PER_LAYER;
        unsigned char* wl = ws + WS_W + (size_t)l * W_LAYER;
        const float* W; const float* gain = nullptr; bf16* WT; int N, K, mode;
        if (r < I_GU) { W = A.in[I_G1] + (size_t)l * D * FF; gain = A.in[I_N1] + l * D; WT = (bf16*)(wl + WO_GU1); N = FF; K = D; mode = 1; }
        else if ((r -= I_GU) < I_GU) { W = A.in[I_U1] + (size_t)l * D * FF; gain = A.in[I_N1] + l * D; WT = (bf16*)(wl + WO_GU1); N = FF; K = D; mode = 2; }
        else if ((r -= I_GU) < I_DN) { W = A.in[I_D1] + (size_t)l * D * FF; WT = (bf16*)(wl + WO_D1); N = D; K = FF; mode = 0; }
        else if ((r -= I_DN) < I_IN) { W = A.in[I_WIN] + (size_t)l * D * DPROJ; gain = A.in[I_NM] + l * D; WT = (bf16*)(wl + WO_IN); N = DPROJ; K = D; mode = 3; }
        else if ((r -= I_IN) < I_OUT) { W = A.in[I_WOUT] + (size_t)l * D * D; WT = (bf16*)(wl + WO_OUT); N = D; K = D; mode = 0; }
        else if ((r -= I_OUT) < I_GU) { W = A.in[I_G2] + (size_t)l * D * FF; gain = A.in[I_N2] + l * D; WT = (bf16*)(wl + WO_GU2); N = FF; K = D; mode = 1; }
        else if ((r -= I_GU) < I_GU) { W = A.in[I_U2] + (size_t)l * D * FF; gain = A.in[I_N2] + l * D; WT = (bf16*)(wl + WO_GU2); N = FF; K = D; mode = 2; }
        else { r -= I_GU; W = A.in[I_D2] + (size_t)l * D * FF; WT = (bf16*)(wl + WO_D2); N = D; K = FF; mode = 0; }
        const int nblk = N / 32, kb = r / nblk, nb = r % nblk, k0 = 64 * kb, n0 = 32 * nb;
        const int dr = mode == 0 ? n0 : (mode == 3 ? map_in(n0) : map_gu(n0, mode == 2));
        p0_transpose_item(W, N, K, WT, dr, gain, scr, k0, n0, lane);
    }
    const int gt = blockIdx.x * (NWAVES * 64) + F.tid, NGT = F.G * NWAVES * 64;
    for (int i = gt; i < DEPTH * 128 * D / 8; i += NGT) { const int l = i / (128 * D / 8), r = i % (128 * D / 8);
        *(GAS v4u*)(ws + WS_W + (size_t)l * W_LAYER + WO_IN + (size_t)DPROJ * D * 2 + (size_t)r * 16) = (v4u){0u, 0u, 0u, 0u}; }
    for (int r = gw; r < DEPTH * 4 * 128; r += NGW) { const int l = r >> 9, rr = r & 511, t = rr & 127; float sum = 0.f;
        GAS bf16* wm = (GAS bf16*)(ws + WS_W + (size_t)l * W_LAYER + WO_S) + (size_t)rr * 128;
#pragma unroll
        for (int i = 0; i < 2; ++i) { const int sidx = lane + 64 * i; const unsigned mb = sidx <= t ? f2bf(A.in[I_WS][(size_t)r * 128 + sidx]) : 0u; wm[sidx] = (bf16)mb; sum += __uint_as_float(mb << 16); }
        sum = wave_sum(sum);
        if (lane == 0) ((GAS float*)(ws + WS_W + (size_t)l * W_LAYER + WO_RSW))[rr] = sum; }
    GAS float* rowss = (GAS float*)(ws + WS_ROWSS);
    for (int i = gt; i < 6 * M; i += NGT) rowss[M + i] = 0.f;
    const float* x = A.in[I_X]; GAS bf16* xb = (GAS bf16*)(ws + WS_XB);
    for (int m0 = gw * 4; m0 < M; m0 += NGW * 4) {
        f32x4 v[4][4]; float sq[4];
#pragma unroll
        for (int r = 0; r < 4; ++r) { const GAS f32x4* xr = (const GAS f32x4*)(x + (size_t)(m0 + r) * D) + lane;
#pragma unroll
            for (int j = 0; j < 4; ++j) v[r][j] = xr[64 * j]; }
#pragma unroll
        for (int r = 0; r < 4; ++r) { float s = 0.f;
#pragma unroll
            for (int j = 0; j < 4; ++j) s += (v[r][j].x * v[r][j].x + v[r][j].y * v[r][j].y) + (v[r][j].z * v[r][j].z + v[r][j].w * v[r][j].w);
            sq[r] = s; }
#pragma unroll
        for (int o = 1; o < 64; o <<= 1) {
#pragma unroll
            for (int r = 0; r < 4; ++r) sq[r] += __shfl_xor(sq[r], o); }
#pragma unroll
        for (int r = 0; r < 4; ++r) { GAS v2u* o8 = (GAS v2u*)(xb + (size_t)(m0 + r) * D) + lane;
#pragma unroll
            for (int j = 0; j < 4; ++j) o8[64 * j] = (v2u){pk2(v[r][j].x, v[r][j].y), pk2(v[r][j].z, v[r][j].w)}; }
        if (lane < 4) rowss[m0 + lane] = lane == 0 ? sq[0] : (lane == 1 ? sq[1] : (lane == 2 ? sq[2] : sq[3]));
    }
}

__device__ __forceinline__ void final_phase(Frame& F, const Args& A) {
    unsigned char* ws = A.ws; LAUNDER_S(ws);
    int tid_ = threadIdx.x; asm volatile("" : "+v"(tid_));
    const int gw = blockIdx.x * NWAVES + F.wave, NGW = F.G * NWAVES, lane = tid_ & 63;
    const GAS float* rowss = (const GAS float*)(ws + WS_ROWSS) + 6 * (size_t)M; const float* g = A.in[I_NF]; const GAS bf16* xb = (const GAS bf16*)(ws + WS_XB);
    f32x4 gv[4];
#pragma unroll
    for (int j = 0; j < 4; ++j) gv[j] = *((const f32x4*)g + lane + 64 * j);
    for (int m0 = gw * 4; m0 < M; m0 += NGW * 4) {
        v2u xv[4][4]; float rs[4];
#pragma unroll
        for (int r = 0; r < 4; ++r) { rs[r] = rowss[m0 + r]; const GAS v2u* xr = (const GAS v2u*)(xb + (size_t)(m0 + r) * D) + lane;
#pragma unroll
            for (int j = 0; j < 4; ++j) xv[r][j] = xr[64 * j]; }
#pragma unroll
        for (int r = 0; r < 4; ++r) { const float sc = __builtin_amdgcn_rsqf(rs[r] * (1.0f / 1024.0f) + RMS_EPS); GAS f32x4* orow = (GAS f32x4*)(A.out + (size_t)(m0 + r) * D) + lane;
#pragma unroll
            for (int j = 0; j < 4; ++j) { const f32x4 v = (f32x4){bflo(xv[r][j].x), bfhi(xv[r][j].x), bflo(xv[r][j].y), bfhi(xv[r][j].y)}; orow[64 * j] = v * sc * gv[j]; } }
    }
}

constexpr int TA_ROW = 784;
constexpr int ST_OFF = 158 * TA_ROW;
constexpr int HOLD_OFF = RING_BYTES + 2048;
constexpr int VT_STR = 132;
static_assert(ST_OFF + 1024 <= RING_BYTES && 256 * VT_STR * 2 <= RING_BYTES && HOLD_OFF + 32 * TA_ROW <= LDS_BYTES, "mixer LDS");
typedef float f32x2 __attribute__((ext_vector_type(2)));
__device__ __forceinline__ float quad_sum(float v) {
    v += __builtin_bit_cast(float, __builtin_amdgcn_update_dpp(0, __builtin_bit_cast(int, v), 0xB1, 0xF, 0xF, true));
    v += __builtin_bit_cast(float, __builtin_amdgcn_update_dpp(0, __builtin_bit_cast(int, v), 0x4E, 0xF, 0xF, true));
    return v;
}
__device__ __forceinline__ void mixer_c_item(const GAS bf16* P, GAS bf16* MX, const float* ccw, int tok0, int pos0, int it) {
    const int t = it / 48, c8 = it % 48; const int pos = pos0 + t;
    const GAS bf16* base = P + (size_t)(tok0 + t) * PACT_W;
    const v4u x0 = *(const GAS v4u*)(base + P_CX + c8 * 8); v4u x1 = (v4u){0u, 0u, 0u, 0u}, x2 = x1;
    if (pos >= 1) x1 = *(const GAS v4u*)(base - PACT_W + P_CX + c8 * 8);
    if (pos >= 2) x2 = *(const GAS v4u*)(base - 2 * PACT_W + P_CX + c8 * 8);
    const v4u cb = *(const GAS v4u*)(base + P_CB + c8 * 8);
    const f32x4 w0a = *(const f32x4*)(ccw + 0 * DC + c8 * 8), w0b = *(const f32x4*)(ccw + 0 * DC + c8 * 8 + 4);
    const f32x4 w1a = *(const f32x4*)(ccw + 1 * DC + c8 * 8), w1b = *(const f32x4*)(ccw + 1 * DC + c8 * 8 + 4);
    const f32x4 w2a = *(const f32x4*)(ccw + 2 * DC + c8 * 8), w2b = *(const f32x4*)(ccw + 2 * DC + c8 * 8 + 4);
    v4u o;
#pragma unroll
    for (int e = 0; e < 4; ++e) {
        const float wl0 = e < 2 ? w0a[2 * e] : w0b[2 * e - 4], wh0 = e < 2 ? w0a[2 * e + 1] : w0b[2 * e - 3];
        const float wl1 = e < 2 ? w1a[2 * e] : w1b[2 * e - 4], wh1 = e < 2 ? w1a[2 * e + 1] : w1b[2 * e - 3];
        const float wl2 = e < 2 ? w2a[2 * e] : w2b[2 * e - 4], wh2 = e < 2 ? w2a[2 * e + 1] : w2b[2 * e - 3];
        const float lo_ = bflo(cb[e]) * (wl0 * bflo(x2[e]) + wl1 * bflo(x1[e]) + wl2 * bflo(x0[e]));
        const float hi_ = bfhi(cb[e]) * (wh0 * bfhi(x2[e]) + wh1 * bfhi(x1[e]) + wh2 * bfhi(x0[e]));
        o[e] = pk2(lo_, hi_); }
    *(GAS v4u*)(MX + (size_t)(tok0 + t) * D + MIX_C + c8 * 8) = o;
}
__device__ __forceinline__ void mixer_phase(Frame& F, const Args& A, int l) {
    unsigned char* ws = A.ws; LAUNDER_S(ws);
    int tid_ = threadIdx.x; asm volatile("" : "+v"(tid_)); const int tid = tid_, lane = tid & 63, wave = F.wave;
    const GAS bf16* P = (const GAS bf16*)(ws + WS_PACT); GAS bf16* MX = (GAS bf16*)(ws + WS_MIX);
    const float* caw = A.in[I_CAW] + l * 31 * DA; const float* cab = A.in[I_CAB] + l * DA;
    const float* lag = A.in[I_LAG] + l * DA; const float* lab = A.in[I_LAB] + l * DA;
    const float* lvg = A.in[I_LVG] + l * DB; const float* lvb = A.in[I_LVB] + l * DB;
    const float* bs = A.in[I_BS] + l * 4 * CHUNK; const float* ccw = A.in[I_CCW] + l * 3 * DC;
    const GAS bf16* Wm = (const GAS bf16*)(ws + WS_W + (size_t)l * W_LAYER + WO_S);
    const GAS float* RSW = (const GAS float*)(ws + WS_W + (size_t)l * W_LAYER + WO_RSW);
    LAS unsigned char* T = F.lds + RING_OFF;
    LAS f32x2* ST = (LAS f32x2*)(T + ST_OFF);
    for (int q = blockIdx.x; q < NCHUNK; q += F.G) {
        const int tok0 = q * CHUNK; const int pos0 = (q & 15) * CHUNK;
        for (int p = tid; p < 158 * 48; p += NWAVES * 64) { const int j = p / 48, c8 = p % 48; v4u v = (v4u){0u, 0u, 0u, 0u};
            if (pos0 + j >= 30) v = *(const GAS v4u*)(P + (size_t)(tok0 - 30 + j) * PACT_W + P_GLU + c8 * 8);
            *(LAS v4u*)(T + j * TA_ROW + c8 * 16) = v; }
        __syncthreads();
        if (wave < 6) {
            const int half = wave >= 3 ? 1 : 0, p = tid - half * 192; f32x2 w2[31];
#pragma unroll
            for (int k = 0; k < 31; ++k) w2[k] = *(const f32x2*)(caw + k * DA + 2 * p);
            const f32x2 bias2 = *(const f32x2*)(cab + 2 * p);
            LAS unsigned char* colp = T + 4 * p;
#define CONV_LOOP(NB, RD, WR) do { LAS unsigned char* rd_ = (RD); LAS unsigned char* wr_ = (WR); \
                _Pragma("unroll 1") for (int tb = 0; tb < (NB); ++tb, rd_ += 4 * TA_ROW, wr_ += 4 * TA_ROW) { f32x2 in2[34]; \
                    _Pragma("unroll") for (int i = 0; i < 34; ++i) { const unsigned wd = *(const LAS unsigned*)(rd_ + i * TA_ROW); in2[i] = (f32x2){bflo(wd), bfhi(wd)}; } \
                    _Pragma("unroll") for (int i = 0; i < 4; ++i) { f32x2 o = bias2; _Pragma("unroll") for (int k = 0; k < 31; ++k) o = w2[k] * in2[i + k] + o; *(LAS unsigned*)(wr_ + i * TA_ROW) = pk2(o.x, o.y); } } } while (0)
            if (half == 0) { CONV_LOOP(16, colp, colp); }
            else { CONV_LOOP(8, colp + 64 * TA_ROW, F.lds + HOLD_OFF + 4 * p); CONV_LOOP(8, colp + 96 * TA_ROW, colp + 96 * TA_ROW); }
#undef CONV_LOOP
        }
        for (int v = (wave >= 6 ? 0 : 32); v < 36; ++v) { const int it = v < 32 ? (tid - 6 * 64) + 128 * v : 4096 + tid + NWAVES * 64 * (v - 32);
            mixer_c_item(P, MX, ccw, tok0, pos0, it); }
        __syncthreads();
        {
            const int t = tid >> 2, qq = tid & 3; const LAS unsigned char* rp = ((t >= 64 && t < 96) ? (F.lds + HOLD_OFF + (t - 64) * TA_ROW) : (T + t * TA_ROW)) + qq * 192; float s = 0.f, s2 = 0.f;
#pragma unroll
            for (int j = 0; j < 12; ++j) { const v4u d = *(const LAS v4u*)(rp + 16 * j);
#pragma unroll
                for (int e = 0; e < 4; ++e) { const float lo = bflo(d[e]), hi = bfhi(d[e]); s += lo + hi; s2 += lo * lo + hi * hi; } }
            s = quad_sum(s); s2 = quad_sum(s2);
            const float mean = s * (1.0f / DA), var = s2 * (1.0f / DA) - mean * mean;
            if (qq == 0) ST[t] = (f32x2){mean, __builtin_amdgcn_rsqf(fmaxf(var, 0.f) + LN_EPS)};
        }
        __syncthreads();
        {
            float g6[6], b6[6];
#pragma unroll
            for (int j = 0; j < 3; ++j) { const f32x2 gg = *(const f32x2*)(lag + 2 * lane + 128 * j), bb = *(const f32x2*)(lab + 2 * lane + 128 * j); g6[2 * j] = gg.x; g6[2 * j + 1] = gg.y; b6[2 * j] = bb.x; b6[2 * j + 1] = bb.y; }
#pragma unroll 4
            for (int tt = 0; tt < 16; ++tt) { const int t = wave * 16 + tt; const f32x2 st = ST[t]; const LAS unsigned char* rowp = (t >= 64 && t < 96) ? (F.lds + HOLD_OFF + (t - 64) * TA_ROW) : (T + t * TA_ROW);
#pragma unroll
                for (int j = 0; j < 3; ++j) { const unsigned wd = *(const LAS unsigned*)(rowp + 4 * lane + 256 * j);
                    const float y0 = (bflo(wd) - st.x) * st.y * g6[2 * j] + b6[2 * j], y1 = (bfhi(wd) - st.x) * st.y * g6[2 * j + 1] + b6[2 * j + 1];
                    *(GAS unsigned*)(MX + (size_t)(tok0 + t) * D + MIX_A + 2 * lane + 128 * j) = pk2(y0 * sigm(y0), y1 * sigm(y1)); }
            }
        }
        v4u xv[8];
        {   const int t = tid >> 2, qq = tid & 3; const GAS bf16* vr = P + (size_t)(tok0 + t) * PACT_W + P_GV + qq * 64;
#pragma unroll
            for (int j = 0; j < 8; ++j) xv[j] = *(const GAS v4u*)(vr + 8 * j); }
        __syncthreads();
        {
            const int t = tid >> 2, qq = tid & 3; float s = 0.f, s2 = 0.f;
#pragma unroll
            for (int j = 0; j < 8; ++j)
#pragma unroll
                for (int e = 0; e < 4; ++e) { const float lo = bflo(xv[j][e]), hi = bfhi(xv[j][e]); s += lo + hi; s2 += lo * lo + hi * hi; }
            s = quad_sum(s); s2 = quad_sum(s2);
            const float mean = s * (1.0f / DB), rstd = __builtin_amdgcn_rsqf(fmaxf(s2 * (1.0f / DB) - mean * mean, 0.f) + LN_EPS);
            LAS unsigned short* Vt = (LAS unsigned short*)T + (qq * 64) * VT_STR + t;
#pragma unroll
            for (int j = 0; j < 8; ++j)
#pragma unroll
                for (int e = 0; e < 4; ++e) { Vt[(8 * j + 2 * e) * VT_STR] = (unsigned short)f2bf((bflo(xv[j][e]) - mean) * rstd); Vt[(8 * j + 2 * e + 1) * VT_STR] = (unsigned short)f2bf((bfhi(xv[j][e]) - mean) * rstd); }
        }
        const int fr = lane & 15, fq = lane >> 4, trow = 16 * wave + fr, nks = (16 * wave + 15) / 32 + 1;
        bf16x8 wf[4][4];
#pragma unroll
        for (int h = 0; h < 4; ++h)
#pragma unroll
            for (int ks = 0; ks < 4; ++ks) { wf[h][ks] = (bf16x8){0, 0, 0, 0, 0, 0, 0, 0}; if (ks < nks) wf[h][ks] = *(const GAS bf16x8*)(Wm + ((size_t)(h * CHUNK + trow) * CHUNK + 32 * ks + 8 * fq)); }
        __syncthreads();
        {
            const LAS unsigned short* Vt = (const LAS unsigned short*)T;
            const size_t tok = (size_t)(tok0 + trow);
#pragma unroll
            for (int h = 0; h < 4; ++h) {
                f32x4 acc[4];
#pragma unroll
                for (int nt = 0; nt < 4; ++nt) acc[nt] = (f32x4){0.f, 0.f, 0.f, 0.f};
#pragma unroll
                for (int ks = 0; ks < 4; ++ks) if (ks < nks) {
#pragma unroll
                    for (int nt = 0; nt < 4; ++nt) { const LAS unsigned short* vp = Vt + (h * 64 + nt * 16 + fr) * VT_STR + 32 * ks + 8 * fq;
                        const s16x4 v0 = *(const LAS s16x4*)vp, v1 = *(const LAS s16x4*)(vp + 4);
                        const bf16x8 vf = __builtin_shufflevector(v0, v1, 0, 1, 2, 3, 4, 5, 6, 7);
                        acc[nt] = __builtin_amdgcn_mfma_f32_16x16x32_bf16(vf, wf[h][ks], acc[nt], 0, 0, 0); }
                }
                const float bsv = bs[h * CHUNK + trow], rsw = RSW[h * CHUNK + trow];
#pragma unroll
                for (int nt = 0; nt < 4; ++nt) { const int d0 = h * 64 + nt * 16 + 4 * fq;
                    const v2u gu = *(const GAS v2u*)(P + tok * PACT_W + P_GU + d0);
                    const f32x4 gg = *(const f32x4*)(lvg + d0), bb = *(const f32x4*)(lvb + d0);
                    const float o0 = bflo(gu.x) * (gg[0] * acc[nt][0] + bb[0] * rsw + bsv), o1 = bfhi(gu.x) * (gg[1] * acc[nt][1] + bb[1] * rsw + bsv);
                    const float o2 = bflo(gu.y) * (gg[2] * acc[nt][2] + bb[2] * rsw + bsv), o3 = bfhi(gu.y) * (gg[3] * acc[nt][3] + bb[3] * rsw + bsv);
                    *(GAS v2u*)(MX + tok * D + MIX_B + d0) = (v2u){pk2(o0, o1), pk2(o2, o3)}; }
            }
        }
        __syncthreads();
    }
}

__global__ void __launch_bounds__(NWAVES * 64, 2) hybrid_fwd(Args args) {
    extern __shared__ __attribute__((aligned(16))) unsigned char lds[];
    if (args.ph_hi > N_PHASES) cg::this_grid().sync();
    Frame F;
    F.lds = (LAS unsigned char*)lds;
    F.MISC = (volatile LAS unsigned*)(F.lds + MISC_OFF);
    F.tid = threadIdx.x; F.lane = F.tid & 63; F.wave = __builtin_amdgcn_readfirstlane(F.tid >> 6);
    F.G = gridDim.x;
    F.ctl = (gu32*)(args.ws + WS_CTL);
    for (int u = F.tid; u < (LDS_BYTES - LDSCTL_OFF) / 4; u += NWAVES * 64) ((LAS unsigned*)(F.lds + LDSCTL_OFF))[u] = 0u;
    __syncthreads();
    const int lo = args.ph_lo, hi = args.ph_hi;
    const bool multi = (hi - lo) > 1;
    XcdBarrier bar; bar.bar = (unsigned*)(F.ctl + CW_BAR); bar.x = 0; bar.st = nullptr;
    if (multi && !MK_CG_SYNC) bar = xcd_barrier_post((unsigned*)(F.ctl + CW_BAR), F.MISC + 8);
#define IN(k) (lo <= (k) && (k) < hi)
#define BOTH(k) (IN(k) && IN((k) + 1))
#define SEAM(k) do { if (BOTH(k)) { if (MK_CG_SYNC) cg::this_grid().sync(); else xcd_barrier(bar); } } while (0)
#define PHASE_PTRS() unsigned char* ws = args.ws; LAUNDER_S(ws); float* rowss = (float*)(ws + WS_ROWSS); unsigned char* wl = ws + WS_W + (size_t)l * W_LAYER; (void)rowss; (void)wl

    if (IN(0)) { for (int rep = 0; rep <= PROBE_PRO; ++rep) p0_prologue(F, args); SEAM(0); }
#pragma unroll 1
    for (int l = 0; l < DEPTH; ++l) {
        const int pb = 1 + 7 * l;
        if (IN(pb + 0)) {
            PHASE_PTRS();
            pg8::Gemm g{(const bf16*)(ws + WS_XB), (const bf16*)(wl + WO_GU1), M, NGU, D}; pg8::StaticOrder S; S.init(M, NGU, F.G, (int)blockIdx.x);
            pg8::EpiSwiGLU E{(bf16*)(ws + WS_HID), rowss + (size_t)(3 * l) * M, FF, (LAS float*)(F.lds + RSTBL_OFF)};
            for (int rep = 0; rep <= PROBE_GU; ++rep) { pg8::gemm_phase<pg8::EpiSwiGLU, pg8::StaticOrder, PG8_ALIGN, PG8_SP2>(F.lds + RING_OFF, g, S, E); }
            for (int rep = 0; rep < PROBE_NULLGU; ++rep) { pg8::EpiNull EN; pg8::gemm_phase<pg8::EpiNull, pg8::StaticOrder, PG8_ALIGN, PG8_SP2>(F.lds + RING_OFF, g, S, EN); }
            SEAM(pb + 0);
        }
        if (IN(pb + 1)) {
            PHASE_PTRS();
            pg8::Gemm g{(const bf16*)(ws + WS_HID), (const bf16*)(wl + WO_D1), M, D, FF}; pg8::StaticOrder S; S.init(M, D, F.G, (int)blockIdx.x);
            pg8::EpiResid E{(bf16*)(ws + WS_XB), rowss + (size_t)(3 * l + 1) * M, 0.5f, 1};
            for (int rep = PROBE_D; rep >= 0; --rep) { E.live = (rep == 0); pg8::gemm_phase<pg8::EpiResid, pg8::StaticOrder, PG8_ALIGN, PG8_SP2>(F.lds + RING_OFF, g, S, E); }
            SEAM(pb + 1);
        }
        if (IN(pb + 2)) {
            PHASE_PTRS();
            pg8::Gemm g{(const bf16*)(ws + WS_XB), (const bf16*)(wl + WO_IN), M, NIN, D}; pg8::StaticOrder S; S.init(M, NIN, F.G, (int)blockIdx.x);
            pg8::EpiIn E{(bf16*)(ws + WS_PACT), rowss + (size_t)(3 * l + 1) * M, (LAS float*)(F.lds + RSTBL_OFF)};
            for (int rep = 0; rep <= PROBE_IN; ++rep) { pg8::gemm_phase<pg8::EpiIn, pg8::StaticOrder, PG8_ALIGN, PG8_SP2>(F.lds + RING_OFF, g, S, E); }
            SEAM(pb + 2);
        }
        if (IN(pb + 3)) { for (int rep = 0; rep <= PROBE_MIX; ++rep) mixer_phase(F, args, l); SEAM(pb + 3); }
        if (IN(pb + 4)) {
            PHASE_PTRS();
            pg8::Gemm g{(const bf16*)(ws + WS_MIX), (const bf16*)(wl + WO_OUT), M, D, D}; pg8::StaticOrder S; S.init(M, D, F.G, (int)blockIdx.x);
            pg8::EpiResid E{(bf16*)(ws + WS_XB), rowss + (size_t)(3 * l + 2) * M, 1.0f, 1};
            for (int rep = PROBE_OUT; rep >= 0; --rep) { E.live = (rep == 0); pg8::gemm_phase<pg8::EpiResid, pg8::StaticOrder, PG8_ALIGN, PG8_SP2>(F.lds + RING_OFF, g, S, E); }
            SEAM(pb + 4);
        }
        if (IN(pb + 5)) {
            PHASE_PTRS();
            pg8::Gemm g{(const bf16*)(ws + WS_XB), (const bf16*)(wl + WO_GU2), M, NGU, D}; pg8::StaticOrder S; S.init(M, NGU, F.G, (int)blockIdx.x);
            pg8::EpiSwiGLU E{(bf16*)(ws + WS_HID), rowss + (size_t)(3 * l + 2) * M, FF, (LAS float*)(F.lds + RSTBL_OFF)};
            for (int rep = 0; rep <= PROBE_GU; ++rep) { pg8::gemm_phase<pg8::EpiSwiGLU, pg8::StaticOrder, PG8_ALIGN, PG8_SP2>(F.lds + RING_OFF, g, S, E); }
            SEAM(pb + 5);
        }
        if (IN(pb + 6)) {
            PHASE_PTRS();
            pg8::Gemm g{(const bf16*)(ws + WS_HID), (const bf16*)(wl + WO_D2), M, D, FF}; pg8::StaticOrder S; S.init(M, D, F.G, (int)blockIdx.x);
            pg8::EpiResid E{(bf16*)(ws + WS_XB), rowss + (size_t)(3 * l + 3) * M, 0.5f, 1};
            for (int rep = PROBE_D; rep >= 0; --rep) { E.live = (rep == 0); pg8::gemm_phase<pg8::EpiResid, pg8::StaticOrder, PG8_ALIGN, PG8_SP2>(F.lds + RING_OFF, g, S, E); }
            SEAM(pb + 6);
        }
    }
    if (IN(15)) { for (int rep = 0; rep <= PROBE_FIN; ++rep) final_phase(F, args); }
#undef IN
#undef BOTH
#undef SEAM
#undef PHASE_PTRS
}

extern "C" void kernel_launch(void* const* d_in, const int* in_sizes, int n_in, void* d_out, int out_size, void* d_ws, size_t ws_size, hipStream_t stream) {
    static int grid = 0;
    if (grid == 0) {
        if (n_in != 22 || in_sizes[0] != M * D || out_size != M * D || ws_size < WS_END) { fprintf(stderr, "kernel_launch: shape/workspace mismatch (n_in %d in0 %d out %d ws %zu)\n", n_in, n_in > 0 ? in_sizes[0] : -1, out_size, ws_size); grid = -1; return; }
        int dev = 0, cus = 0, per_cu = 0;
        if (hipGetDevice(&dev) != hipSuccess || hipDeviceGetAttribute(&cus, hipDeviceAttributeMultiprocessorCount, dev) != hipSuccess) { grid = -1; return; }
        if (hipFuncSetAttribute((const void*)hybrid_fwd, hipFuncAttributeMaxDynamicSharedMemorySize, LDS_BYTES) != hipSuccess) { fprintf(stderr, "kernel_launch: hipFuncSetAttribute failed\n"); grid = -1; return; }
        if (hipOccupancyMaxActiveBlocksPerMultiprocessor(&per_cu, (const void*)hybrid_fwd, NWAVES * 64, LDS_BYTES) != hipSuccess || per_cu < 1) { fprintf(stderr, "kernel_launch: occupancy query says %d blocks per CU\n", per_cu); per_cu = 1; }
        (void)hipGetLastError();
        grid = cus * 1;
    }
    if (grid < 0) return;
    (void)hipMemsetAsync((char*)d_ws + WS_CTL, 0, CTL_ZERO_BYTES, stream);
    Args a{};
    for (int i = 0; i < 22; ++i) a.in[i] = (const float*)d_in[i];
    a.out = (float*)d_out; a.ws = (unsigned char*)d_ws;
#if MK_N_LAUNCHES == 1
    a.ph_lo = 0; a.ph_hi = N_PHASES;
    void* kargs[] = {&a};
    hipError_t e = hipLaunchCooperativeKernel((const void*)hybrid_fwd, dim3(grid), dim3(NWAVES * 64), kargs, LDS_BYTES, stream);
    if (e != hipSuccess) fprintf(stderr, "kernel_launch: cooperative launch failed: %s (grid %d)\n", hipGetErrorString(e), grid);
#else
    for (int p = 0; p < N_PHASES; ++p) { a.ph_lo = p; a.ph_hi = p + 1;
        hipLaunchKernelGGL(hybrid_fwd, dim3(grid), dim3(NWAVES * 64), LDS_BYTES, stream, a); }
#endif
}
```

```cpp
#include <hip/hip_runtime.h>
#include <hip/hip_cooperative_groups.h>
#include <cstdio>
#include <cstdint>
namespace cg = cooperative_groups;

#ifndef MK_N_LAUNCHES
#define MK_N_LAUNCHES 1
#endif
#ifndef MK_CG_SYNC
#define MK_CG_SYNC 0
#endif

#ifndef PROBE_GU
#define PROBE_GU 0
#endif
#ifndef PROBE_NULLGU
#define PROBE_NULLGU 0
#endif
#ifndef PROBE_FIXGU
#define PROBE_FIXGU 0
#endif
#ifndef PROBE_D
#define PROBE_D 0
#endif
#ifndef PROBE_IN
#define PROBE_IN 0
#endif
#ifndef PROBE_OUT
#define PROBE_OUT 0
#endif
#ifndef PROBE_MIX
#define PROBE_MIX 0
#endif
#ifndef PROBE_PRO
#define PROBE_PRO 0
#endif
#ifndef PROBE_FIN
#define PROBE_FIN 0
#endif

constexpr int NWAVES = 8;
constexpr int BATCH = 16, SEQ = 2048, M = BATCH * SEQ, D = 1024, FF = 2816, NGU = 2 * FF, DPROJ = 2432, NIN = 2560, DEPTH = 2;
constexpr int DA = 384, DB = 256, DC = 384, PACT_W = 1664, CHUNK = 128, NCHUNK = M / CHUNK;
constexpr int P_GLU = 0, P_GU = 384, P_GV = 640, P_CX = 896, P_CB = 1280;
constexpr int MIX_A = 0, MIX_B = 384, MIX_C = 640;
constexpr float RMS_EPS = 1e-6f, LN_EPS = 1e-5f;
constexpr int N_PHASES = 16;

namespace pg8 {
#define PG8_LAS __attribute__((address_space(3)))
typedef unsigned short bf16_t;
typedef short bf16x8 __attribute__((ext_vector_type(8)));
typedef float f32x4 __attribute__((ext_vector_type(4)));
typedef unsigned u32x4 __attribute__((ext_vector_type(4)));
constexpr int BM = 256, BK = 64, HALF = 128, HTB = HALF * BK * 2  , STAGE_BYTES = 8 * HTB, NXCD = 8, WGM = 8;

__host__ __device__ __forceinline__ int lds_byte(int r, int c) { const int st = (r >> 4) * 2 + (c >> 5), rr = r & 15, cc = c & 31, ob = rr * 64 + cc * 2; return st * 1024 + (ob ^ (((ob >> 9) & 1) << 5)); }
__host__ __device__ __forceinline__ void stage_rc(int b, int& R, int& C) { const int st = b / 1024, sb = b % 1024, swz = sb ^ (((sb >> 9) & 1) << 5); R = (st >> 1) * 16 + swz / 64; C = (st & 1) * 32 + (swz % 64) / 2; }
__host__ __device__ __forceinline__ int perm32(int rho) { const int n = rho >> 4, i = rho & 15; return 8 * (i >> 2) + 4 * n + (i & 3); }

struct Unit { int pm, pn; };
struct Gemm { const bf16_t* A; const bf16_t* Bt; int M, N, K; };

struct StaticOrder {
    int nM, nN, nwg, G, c;
    __host__ __device__ void init(int M, int N, int G_, int c_) { nM = M / BM; nN = N / BM; nwg = nM * nN; G = G_; c = c_; }
    __host__ __device__ bool next(int i, Unit& u) const {
        const long L = (long)i * G + c; if (L >= nwg) return false;
        int wgid = (int)L; { const int q = nwg / NXCD, r = nwg % NXCD, xcd = wgid % NXCD, off = wgid / NXCD; wgid = (xcd < r ? xcd * (q + 1) : r * (q + 1) + (xcd - r) * q) + off; }
        const int nig = WGM * nN, gid = wgid / nig, fm = gid * WGM, gsz = (nM - fm) < WGM ? (nM - fm) : WGM;
        u.pm = fm + ((wgid % nig) % gsz); u.pn = (wgid % nig) / gsz; return true;
    }
    __device__ __forceinline__ void a_ready(const Unit&) const {}
    __device__ __forceinline__ void done(const Unit&) const {}
};

__device__ __forceinline__ unsigned cvt_pk_bf16(float lo, float hi) { unsigned r; asm volatile("v_cvt_pk_bf16_f32 %0, %1, %2" : "=v"(r) : "v"(lo), "v"(hi)); return r; }
__device__ __forceinline__ float sigmoid_f(float x) { return __builtin_amdgcn_rcpf(1.0f + __builtin_amdgcn_exp2f(-1.4426950408889634f * x)); }
__device__ __forceinline__ float gelu_tanh_f(float x) { const float z = x * (1.5957691216057308f + 0.07135481282817f * x * x); return x * sigmoid_f(z); }
__device__ __forceinline__ u32x4 pack8(const f32x4 a, const f32x4 b) { u32x4 w; w.x = cvt_pk_bf16(a[0], a[1]); w.y = cvt_pk_bf16(a[2], a[3]); w.z = cvt_pk_bf16(b[0], b[1]); w.w = cvt_pk_bf16(b[2], b[3]); return w; }
#define PG8_GAS __attribute__((address_space(1)))
__device__ __forceinline__ f32x4 exp4(const f32x4 t) { f32x4 e; e[0] = __builtin_amdgcn_exp2f(t[0]); e[1] = __builtin_amdgcn_exp2f(t[1]); e[2] = __builtin_amdgcn_exp2f(t[2]); e[3] = __builtin_amdgcn_exp2f(t[3]); return e; }
__device__ __forceinline__ f32x4 rcp4(const f32x4 t) { f32x4 e; e[0] = __builtin_amdgcn_rcpf(t[0]); e[1] = __builtin_amdgcn_rcpf(t[1]); e[2] = __builtin_amdgcn_rcpf(t[2]); e[3] = __builtin_amdgcn_rcpf(t[3]); return e; }
__device__ __forceinline__ f32x4 gelu4(const f32x4 x) { const f32x4 z = x * (x * x * -0.10294324f + -2.3022082f); return x * rcp4(exp4(z) + 1.0f); }
__device__ __forceinline__ float rs_of(float ss) { return __builtin_amdgcn_rsqf(ss * (1.0f / 1024.0f) + 1e-6f); }
__device__ __forceinline__ void load_rs(const float* rowss, int row0, float (&rs)[2][4]) {
    const PG8_GAS float* p = (const PG8_GAS float*)rowss + row0;
#pragma unroll
    for (int ai = 0; ai < 2; ++ai)
#pragma unroll
        for (int m = 0; m < 4; ++m) rs[ai][m] = p[ai * HALF + m * 16];
#pragma unroll
    for (int ai = 0; ai < 2; ++ai)
#pragma unroll
        for (int m = 0; m < 4; ++m) rs[ai][m] = rs_of(rs[ai][m]);
}

__device__ __forceinline__ void dma_rowss(const float* rowss, PG8_LAS float* tbl, int pm, int wid, int lane) {
    if (wid < 4) __builtin_amdgcn_global_load_lds((const unsigned*)(rowss + (size_t)pm * BM + wid * 64 + lane), (PG8_LAS unsigned*)(tbl + wid * 64), 4, 0, 0);
}
__device__ __forceinline__ void load_rs_lds(const PG8_LAS float* tbl, int wr, int fr, float (&rs)[2][4]) {
#pragma unroll
    for (int ai = 0; ai < 2; ++ai)
#pragma unroll
        for (int m = 0; m < 4; ++m) rs[ai][m] = rs_of(tbl[ai * HALF + wr * 64 + m * 16 + fr]);
}
struct EpiSwiGLU {
    static constexpr bool PERM = true, AFTER_DRAIN = false;
    bf16_t* H; const float* rowss; int ldh; PG8_LAS float* tbl;
    __device__ __forceinline__ void prefetch(const Unit& u, int wid, int lane) const { dma_rowss(rowss, tbl, u.pm, wid, lane); }
    __device__ __forceinline__ void operator()(const f32x4 (&acc)[2][2][4][2], const Unit& u, int wr, int wc, int fr, int fq) const {
        const int row0 = u.pm * BM + wr * 64 + fr, col0 = u.pn * HALF + wc * 32 + 8 * fq;
        float rsv[2][4]; load_rs_lds(tbl, wr, fr, rsv);
        PG8_GAS bf16_t* hp = (PG8_GAS bf16_t*)H + (size_t)row0 * ldh + col0;
#pragma unroll
        for (int ai = 0; ai < 2; ++ai)
#pragma unroll
            for (int m = 0; m < 4; ++m) { const float rs = rsv[ai][m], c1 = -1.4426950408889634f * rs, q = __builtin_amdgcn_rcpf(rs * rs);
                f32x4 o[2];
#pragma unroll
                for (int n = 0; n < 2; ++n) { const f32x4 g = acc[ai][0][m][n], t = g * c1; f32x4 r;
#pragma unroll
                    for (int j = 0; j < 4; ++j) r[j] = __builtin_amdgcn_rcpf(__builtin_fmaf(__builtin_amdgcn_exp2f(t[j]), q, q));
                    o[n] = (g * acc[ai][1][m][n]) * r; }
                *(PG8_GAS u32x4*)(hp + (size_t)(ai * HALF + m * 16) * ldh) = pack8(o[0], o[1]); }
    }
};
__device__ __forceinline__ float bf_lo(unsigned w) { return __uint_as_float(w << 16); }
__device__ __forceinline__ float bf_hi(unsigned w) { return __uint_as_float(w & 0xffff0000u); }
struct EpiResid {
    static constexpr bool PERM = true, AFTER_DRAIN = false;
    bf16_t* xb; float* rowss; float scale; int live;
    __device__ __forceinline__ void prefetch(const Unit&, int, int) const {}
    __device__ __forceinline__ void operator()(const f32x4 (&acc)[2][2][4][2], const Unit& u, int wr, int wc, int fr, int fq) const {
        const int row0 = u.pm * BM + wr * 64 + fr, col0 = u.pn * BM + wc * 32 + 8 * fq;
        PG8_GAS bf16_t* xp = (PG8_GAS bf16_t*)xb + (size_t)row0 * 1024 + col0; PG8_GAS float* sp = (PG8_GAS float*)rowss + row0;
#pragma unroll
        for (int ai = 0; ai < 2; ++ai) {
            u32x4 x[4][2];
#pragma unroll
            for (int m = 0; m < 4; ++m)
#pragma unroll
                for (int bj = 0; bj < 2; ++bj) x[m][bj] = *(const PG8_GAS u32x4*)(xp + (size_t)(ai * HALF + m * 16) * 1024 + bj * HALF);
#pragma unroll
            for (int m = 0; m < 4; ++m) { float ss = 0.f;
#pragma unroll
                for (int bj = 0; bj < 2; ++bj) { const float sc = live ? scale : 0.f; const f32x4 a0 = acc[ai][bj][m][0] * sc, a1 = acc[ai][bj][m][1] * sc; const u32x4 xv = x[m][bj]; f32x4 v0, v1;
                    v0[0] = bf_lo(xv[0]) + a0[0]; v0[1] = bf_hi(xv[0]) + a0[1]; v0[2] = bf_lo(xv[1]) + a0[2]; v0[3] = bf_hi(xv[1]) + a0[3];
                    v1[0] = bf_lo(xv[2]) + a1[0]; v1[1] = bf_hi(xv[2]) + a1[1]; v1[2] = bf_lo(xv[3]) + a1[2]; v1[3] = bf_hi(xv[3]) + a1[3];
                    *(PG8_GAS u32x4*)(xp + (size_t)(ai * HALF + m * 16) * 1024 + bj * HALF) = pack8(v0, v1);
                    ss += (v0[0] * v0[0] + v0[1] * v0[1]) + (v0[2] * v0[2] + v0[3] * v0[3]) + (v1[0] * v1[0] + v1[1] * v1[1]) + (v1[2] * v1[2] + v1[3] * v1[3]); }
                ss += __shfl_xor(ss, 16); ss += __shfl_xor(ss, 32);
                if (fq == 0 && live) (void)__builtin_amdgcn_global_atomic_fadd_f32(sp + ai * HALF + m * 16, ss); }
        }
    }
};
struct EpiIn {
    static constexpr bool PERM = true, AFTER_DRAIN = false;
    bf16_t* P; const float* rowss; PG8_LAS float* tbl;
    __device__ __forceinline__ void prefetch(const Unit& u, int wid, int lane) const { dma_rowss(rowss, tbl, u.pm, wid, lane); }
    __device__ __forceinline__ void operator()(const f32x4 (&acc)[2][2][4][2], const Unit& u, int wr, int wc, int fr, int fq) const {
        const int row0 = u.pm * BM + wr * 64 + fr, cw = wc * 32 + 8 * fq, pn = u.pn;
        float rsv[2][4]; load_rs_lds(tbl, wr, fr, rsv);
        PG8_GAS bf16_t* pp = (PG8_GAS bf16_t*)P + (size_t)row0 * 1664 + cw;
#pragma unroll
        for (int ai = 0; ai < 2; ++ai)
#pragma unroll
            for (int m = 0; m < 4; ++m) { const float rs = rsv[ai][m];
                PG8_GAS bf16_t* rp = pp + (size_t)(ai * HALF + m * 16) * 1664;
                const f32x4 A0 = acc[ai][0][m][0], A1 = acc[ai][0][m][1], B0 = acc[ai][1][m][0], B1 = acc[ai][1][m][1];
                if (pn < 3) { const float c1 = -1.4426950408889634f * rs;
                    *(PG8_GAS u32x4*)(rp + 0 + pn * HALF) = pack8(A0 * (rcp4(exp4(B0 * c1) + 1.0f) * rs), A1 * (rcp4(exp4(B1 * c1) + 1.0f) * rs));
                } else if (pn < 5) {
                    *(PG8_GAS u32x4*)(rp + 384 + (pn - 3) * BM) = pack8(gelu4(A0 * rs), gelu4(A1 * rs)); *(PG8_GAS u32x4*)(rp + 384 + (pn - 3) * BM + HALF) = pack8(gelu4(B0 * rs), gelu4(B1 * rs));
                } else if (pn < 8) { const float rs2 = rs * rs;
                    *(PG8_GAS u32x4*)(rp + 896 + (pn - 5) * HALF) = pack8(A0 * B0 * rs2, A1 * B1 * rs2);
                } else if (pn == 8) {
                    *(PG8_GAS u32x4*)(rp + 1280) = pack8(A0 * rs, A1 * rs); *(PG8_GAS u32x4*)(rp + 1280 + HALF) = pack8(B0 * rs, B1 * rs);
                } else {
                    *(PG8_GAS u32x4*)(rp + 1280 + BM) = pack8(A0 * rs, A1 * rs);
                } }
    }
};

struct EpiNull {
    static constexpr bool PERM = true, AFTER_DRAIN = false;
    __device__ __forceinline__ void prefetch(const Unit&, int, int) const {}
    __device__ __forceinline__ void operator()(const f32x4 (&acc)[2][2][4][2], const Unit& u, int wr, int wc, int fr, int fq) const {
#pragma unroll
        for (int ai = 0; ai < 2; ++ai)
#pragma unroll
            for (int bj = 0; bj < 2; ++bj)
#pragma unroll
                for (int m = 0; m < 4; ++m)
#pragma unroll
                    for (int n = 0; n < 2; ++n) asm volatile("" :: "v"(acc[ai][bj][m][n]));
    }
};

template <class Epi, class Sched, bool ALIGN_EPI = false, bool SP2 = false>
__device__ __forceinline__ void gemm_phase(PG8_LAS unsigned char* lds, const Gemm g, const Sched& S, const Epi& E) {
    int tid_ = threadIdx.x; asm volatile("" : "+v"(tid_)); const int tid = tid_, wid = __builtin_amdgcn_readfirstlane(tid >> 6), lane = tid & 63, wr = wid >> 2, wc = wid & 3, fr = lane & 15, fq = lane >> 4;
    const int K = g.K, nt = K / BK;
    unsigned voffA[2], voffB[2];
#pragma unroll
    for (int i = 0; i < 2; ++i) { int R, C; stage_rc(tid * 16 + i * 8192, R, C); const int Rb = Epi::PERM ? ((R & ~31) + perm32(R & 31)) : R;
        voffA[i] = (unsigned)(R * K + C) * 2u; voffB[i] = (unsigned)(Rb * K + C) * 2u; }
    const int kstep = BK * 2;
    const int hstep = HALF * K * 2;
    const int tstep = 2 * hstep;
    const unsigned ldsw = (unsigned)wid * 1024u;
    const int aoff = lds_byte(wr * 64 + fr, fq * 8), boff = lds_byte(wc * 32 + fr, fq * 8);
#define PG8_SA(b, h) (((b) * 2 + (h)) * HTB)
#define PG8_SB(b, h) ((4 + (b) * 2 + (h)) * HTB)
#define PG8_STAGE(bufoff, rsrc, soff, voff) do { _Pragma("unroll") for (int _i = 0; _i < 2; ++_i) \
        __builtin_amdgcn_raw_ptr_buffer_load_lds((rsrc), (PG8_LAS void*)(lds + (bufoff) + ldsw + _i * 8192), 16, (int)(voff)[_i], (soff), 0, 0); } while (0)
#define PG8_LDA(dst, b, h) do { _Pragma("unroll") for (int m = 0; m < 4; ++m) _Pragma("unroll") for (int k = 0; k < 2; ++k) dst[m][k] = *(const PG8_LAS bf16x8*)(lds + PG8_SA(b, h) + aoff + m * 2048 + k * 1024); } while (0)
#define PG8_LDB(dst, b, h) do { _Pragma("unroll") for (int n = 0; n < 2; ++n) _Pragma("unroll") for (int k = 0; k < 2; ++k) dst[n][k] = *(const PG8_LAS bf16x8*)(lds + PG8_SB(b, h) + boff + n * 2048 + k * 1024); } while (0)
#define PG8_MMA(ai, bj, At, Bt) do { __builtin_amdgcn_s_setprio(1); _Pragma("unroll") for (int m = 0; m < 4; ++m) _Pragma("unroll") for (int n = 0; n < 2; ++n) _Pragma("unroll") for (int k = 0; k < 2; ++k) \
        acc[ai][bj][m][n] = __builtin_amdgcn_mfma_f32_16x16x32_bf16(Bt[n][k], At[m][k], acc[ai][bj][m][n], 0, 0, 0); __builtin_amdgcn_s_setprio(0); } while (0)
#define PG8_WAIT_V(n) asm volatile("s_waitcnt vmcnt(" #n ")" ::: "memory")
#define PG8_WAIT_L(n) asm volatile("s_waitcnt lgkmcnt(" #n ")" ::: "memory")
#define PG8_BAR __builtin_amdgcn_s_barrier()
#define PG8_SCHED __builtin_amdgcn_sched_barrier(0)
    Unit cur, nxt; int ui = 0;
    if (!S.next(0, cur)) return;
    f32x4 acc[2][2][4][2];
#pragma unroll
    for (int a = 0; a < 2; ++a)
#pragma unroll
        for (int b = 0; b < 2; ++b)
#pragma unroll
            for (int m = 0; m < 4; ++m)
#pragma unroll
                for (int n = 0; n < 2; ++n) acc[a][b][m][n] = (f32x4){0.f, 0.f, 0.f, 0.f};
    bf16x8 At[4][2], B0[2][2], B1[2][2];
    int cA = cur.pm * tstep, cB = cur.pn * tstep;
    const __amdgpu_buffer_rsrc_t rA = __builtin_amdgcn_make_buffer_rsrc((void*)g.A, 0, g.M * K * 2, 0x00020000), rB = __builtin_amdgcn_make_buffer_rsrc((void*)g.Bt, 0, g.N * K * 2, 0x00020000);
    S.a_ready(cur);
    if constexpr (SP2) {
        PG8_STAGE(PG8_SB(0, 0), rB, cB, voffB); PG8_STAGE(PG8_SB(0, 1), rB, cB + hstep, voffB); PG8_STAGE(PG8_SA(0, 0), rA, cA, voffA); PG8_STAGE(PG8_SA(0, 1), rA, cA + hstep, voffA);
        if (wr == 1) PG8_BAR;
        PG8_WAIT_V(2); PG8_BAR;
        PG8_STAGE(PG8_SB(1, 0), rB, cB + kstep, voffB); PG8_STAGE(PG8_SA(1, 0), rA, cA + kstep, voffA); PG8_STAGE(PG8_SB(1, 1), rB, cB + hstep + kstep, voffB);
        PG8_WAIT_V(6); PG8_BAR;
    } else {
        PG8_STAGE(PG8_SB(0, 0), rB, cB, voffB); PG8_STAGE(PG8_SA(0, 0), rA, cA, voffA); PG8_STAGE(PG8_SB(0, 1), rB, cB + hstep, voffB); PG8_STAGE(PG8_SA(0, 1), rA, cA + hstep, voffA);
        if (wr == 1) PG8_BAR;
        PG8_WAIT_V(4); PG8_BAR;
        PG8_STAGE(PG8_SB(1, 0), rB, cB + kstep, voffB); PG8_STAGE(PG8_SA(1, 0), rA, cA + kstep, voffA); PG8_STAGE(PG8_SB(1, 1), rB, cB + hstep + kstep, voffB);
        PG8_WAIT_V(6); PG8_BAR;
    }
    for (;;) {
        const bool has_next = S.next(ui + 1, nxt);
        const int nA = has_next ? nxt.pm * tstep : cA, nB = has_next ? nxt.pn * tstep : cB;
        for (int t = 0; t < nt; t += 2) {
            const bool last = (t == nt - 2);
            const int a1 = cA + (t + 1) * kstep;
            const int a2 = last ? nA : cA + (t + 2) * kstep, b2 = last ? nB : cB + (t + 2) * kstep;
            const int a3 = a2 + kstep, b3 = b2 + kstep;
            if (last && has_next) S.a_ready(nxt);
            if (last) E.prefetch(cur, wid, lane);
            if constexpr (SP2) {
            PG8_LDB(B0, 0, 0); PG8_LDB(B1, 0, 1); PG8_SCHED; PG8_LDA(At, 0, 0); PG8_STAGE(PG8_SA(1, 1), rA, a1 + hstep, voffA);
            PG8_WAIT_V(8); PG8_WAIT_L(0); PG8_BAR; PG8_MMA(0, 0, At, B0); PG8_MMA(0, 1, At, B1); PG8_BAR; PG8_SCHED;
            PG8_LDA(At, 0, 1); PG8_STAGE(PG8_SB(0, 0), rB, b2, voffB); PG8_STAGE(PG8_SB(0, 1), rB, b2 + hstep, voffB); PG8_STAGE(PG8_SA(0, 0), rA, a2, voffA);
            PG8_WAIT_V(8); PG8_WAIT_L(0); PG8_BAR; PG8_MMA(1, 0, At, B0); PG8_MMA(1, 1, At, B1); PG8_BAR; PG8_SCHED;
            PG8_LDB(B0, 1, 0); PG8_LDB(B1, 1, 1); PG8_SCHED; PG8_LDA(At, 1, 0); PG8_STAGE(PG8_SA(0, 1), rA, a2 + hstep, voffA);
            PG8_WAIT_V(8); PG8_WAIT_L(0); PG8_BAR; PG8_MMA(0, 0, At, B0); PG8_MMA(0, 1, At, B1); PG8_BAR; PG8_SCHED;
            PG8_LDA(At, 1, 1); PG8_STAGE(PG8_SB(1, 0), rB, b3, voffB); PG8_STAGE(PG8_SB(1, 1), rB, b3 + hstep, voffB); PG8_STAGE(PG8_SA(1, 0), rA, a3, voffA);
            PG8_WAIT_V(8); PG8_WAIT_L(0); PG8_BAR; PG8_MMA(1, 0, At, B0); PG8_MMA(1, 1, At, B1); PG8_BAR; PG8_SCHED;
            } else {
            PG8_LDB(B0, 0, 0); PG8_SCHED; PG8_LDA(At, 0, 0); PG8_STAGE(PG8_SA(1, 1), rA, a1 + hstep, voffA);
            PG8_WAIT_L(8); PG8_BAR; PG8_WAIT_L(0); PG8_MMA(0, 0, At, B0); PG8_BAR; PG8_SCHED;
            PG8_LDB(B1, 0, 1); PG8_STAGE(PG8_SB(0, 0), rB, b2, voffB);
            PG8_BAR; PG8_WAIT_L(0); PG8_MMA(0, 1, At, B1); PG8_BAR;
            PG8_LDA(At, 0, 1); PG8_STAGE(PG8_SA(0, 0), rA, a2, voffA);
            PG8_BAR; PG8_WAIT_L(0); PG8_MMA(1, 0, At, B0); PG8_BAR; PG8_SCHED;
            PG8_STAGE(PG8_SB(0, 1), rB, b2 + hstep, voffB);
            PG8_WAIT_V(6); PG8_BAR; PG8_MMA(1, 1, At, B1); PG8_BAR;
            PG8_LDB(B0, 1, 0); PG8_SCHED; PG8_LDA(At, 1, 0); PG8_STAGE(PG8_SA(0, 1), rA, a2 + hstep, voffA);
            PG8_WAIT_L(8); PG8_BAR; PG8_WAIT_L(0); PG8_MMA(0, 0, At, B0); PG8_BAR; PG8_SCHED;
            PG8_LDB(B1, 1, 1); PG8_STAGE(PG8_SB(1, 0), rB, b3, voffB);
            PG8_BAR; PG8_WAIT_L(0); PG8_MMA(0, 1, At, B1); PG8_BAR;
            PG8_LDA(At, 1, 1); PG8_STAGE(PG8_SA(1, 0), rA, a3, voffA);
            PG8_BAR; PG8_WAIT_L(0); PG8_MMA(1, 0, At, B0); PG8_BAR; PG8_SCHED;
            PG8_STAGE(PG8_SB(1, 1), rB, b3 + hstep, voffB);
            PG8_WAIT_V(6); PG8_BAR; PG8_MMA(1, 1, At, B1); PG8_BAR;
            }
        }
        if constexpr (ALIGN_EPI) { if (wr == 0) PG8_BAR; }
        if constexpr (!Epi::AFTER_DRAIN) { E(acc, cur, wr, wc, fr, fq); S.done(cur); }
        if (!has_next) break;
#pragma unroll
        for (int a = 0; a < 2; ++a)
#pragma unroll
            for (int b = 0; b < 2; ++b)
#pragma unroll
                for (int m = 0; m < 4; ++m)
#pragma unroll
                    for (int n = 0; n < 2; ++n) acc[a][b][m][n] = (f32x4){0.f, 0.f, 0.f, 0.f};
        cur = nxt; cA = nA; cB = nB; ++ui;
        if constexpr (ALIGN_EPI) { if (wr == 1) PG8_BAR; }
    }
    PG8_WAIT_V(0);
    if constexpr (!ALIGN_EPI) { if (wr == 0) PG8_BAR; }
    PG8_BAR;
    if constexpr (Epi::AFTER_DRAIN) { E.fused(acc, cur, wr, wc, fr, fq, lds, wid, lane); S.done(cur); }
#undef PG8_SA
#undef PG8_SB
#undef PG8_STAGE
#undef PG8_LDA
#undef PG8_LDB
#undef PG8_MMA
#undef PG8_WAIT_V
#undef PG8_WAIT_L
#undef PG8_BAR
#undef PG8_SCHED
}
}

#ifndef PG8_SP2
#define PG8_SP2 true
#endif
#ifndef PG8_ALIGN
#define PG8_ALIGN true
#endif

constexpr size_t MiB = 1u << 20;
constexpr size_t WS_CTL = 0, CTL_ZERO_BYTES = 64 * 1024;
constexpr size_t WS_ROWSS = 1 * MiB;
constexpr size_t WS_W = 2 * MiB, W_LAYER = 41 * MiB;
constexpr size_t WO_GU1 = 0, WO_D1 = 11 * MiB, WO_IN = 17 * MiB, WO_OUT = 22 * MiB, WO_GU2 = 24 * MiB, WO_D2 = 35 * MiB, WO_S = 40 * MiB + 512 * 1024, WO_RSW = WO_S + 4 * 128 * 128 * 2;
constexpr size_t WS_XB = 84 * MiB;
constexpr size_t WS_HID = 148 * MiB;
constexpr size_t WS_PACT = 148 * MiB, WS_MIX = 252 * MiB;
constexpr size_t WS_END = 324 * MiB;
static_assert(WO_D1 >= (size_t)NGU * D * 2 && WO_IN - WO_D1 >= (size_t)D * FF * 2 && WO_OUT - WO_IN >= (size_t)NIN * D * 2 && WO_S - WO_D2 >= (size_t)D * FF * 2 && WO_RSW + 4 * 128 * 4 <= W_LAYER, "weight map");
static_assert(WS_W + DEPTH * W_LAYER <= WS_XB && WS_XB + (size_t)M * D * 2 <= WS_HID && WS_HID + (size_t)M * FF * 2 <= WS_END && WS_PACT + (size_t)M * PACT_W * 2 <= WS_MIX && WS_MIX + (size_t)M * D * 2 <= WS_END, "d_ws map");
constexpr int CW_BAR = 1024;

constexpr int RING_OFF = 0, RING_BYTES = 131072;
constexpr int LDSCTL_OFF = RING_BYTES, MISC_OFF = LDSCTL_OFF + 320;
constexpr int RSTBL_OFF = RING_BYTES + 2048;
constexpr int LDS_BYTES = 163840;
static_assert(MISC_OFF + 128 <= LDS_BYTES, "LDS map");

#define GAS __attribute__((address_space(1)))
#define LAS __attribute__((address_space(3)))
typedef unsigned short bf16;
typedef unsigned v4u __attribute__((ext_vector_type(4)));
typedef unsigned v2u __attribute__((ext_vector_type(2)));
typedef float f32x4 __attribute__((ext_vector_type(4)));
typedef short bf16x8 __attribute__((ext_vector_type(8)));
typedef short s16x4 __attribute__((ext_vector_type(4)));
typedef GAS unsigned gu32;
#define RLX_AGENT __ATOMIC_RELAXED, __HIP_MEMORY_SCOPE_AGENT
#define LDS_WAIT() asm volatile("s_waitcnt lgkmcnt(0)" ::: "memory")
#define VM_WAIT() asm volatile("s_waitcnt vmcnt(0)" ::: "memory")
typedef float cvt_f32x2 __attribute__((ext_vector_type(2)));
typedef __bf16 cvt_bf16x2 __attribute__((ext_vector_type(2)));
__device__ __forceinline__ unsigned pk2(float lo, float hi) { return __builtin_bit_cast(unsigned, __builtin_convertvector((cvt_f32x2){lo, hi}, cvt_bf16x2)); }
__device__ __forceinline__ unsigned f2bf(float f) { return pk2(f, 0.f) & 0xffffu; }
__device__ __forceinline__ float bflo(unsigned w) { return __uint_as_float(w << 16); }
__device__ __forceinline__ float bfhi(unsigned w) { return __uint_as_float(w & 0xffff0000u); }
__device__ __forceinline__ float sigm(float x) { return __builtin_amdgcn_rcpf(1.0f + __builtin_amdgcn_exp2f(-1.4426950408889634f * x)); }

#define XB_TMO      128
#define XB_XCNT(j)  (256  + 64 * (j))
#define XB_XSUB(j)  (1280 + 64 * (j))
#define XB_XGEN(j)  (2304 + 64 * (j))
#define XB_TOP      3328
#define XB_TOPGEN   3392
#define XCD_BAR_WORDS 3456
#define XB_SPIN_CAP (1u << 18)

__device__ __forceinline__ unsigned xb_ld(GAS unsigned* p)          { return __hip_atomic_load(p, __ATOMIC_RELAXED, __HIP_MEMORY_SCOPE_AGENT); }
__device__ __forceinline__ unsigned xb_add(GAS unsigned* p, unsigned v) { return __hip_atomic_fetch_add(p, v, __ATOMIC_RELAXED, __HIP_MEMORY_SCOPE_AGENT); }
__device__ __forceinline__ unsigned xb_xcc_id() { return (unsigned)__builtin_amdgcn_s_getreg((3 << 11) | 20) & 0xFu; }
#define XB_SPIN(cond, bar) do { unsigned _sp = 0; while (cond) { __builtin_amdgcn_s_sleep(1); \
    if ((++_sp & 255u) == 0u) { if (xb_ld(&(bar)[XB_TMO])) break; if (_sp > XB_SPIN_CAP) { atomicAdd((unsigned*)&(bar)[XB_TMO], 1u); break; } } } } while (0)

struct XcdBarrier {
    unsigned* bar; unsigned x;
    volatile LAS unsigned* st;
};

__device__ __forceinline__ XcdBarrier xcd_barrier_post(unsigned* bar, volatile LAS unsigned* st) {
    XcdBarrier b; b.bar = bar; b.x = xb_xcc_id(); b.st = st;
    if (threadIdx.x == 0) (void)xb_add((GAS unsigned*)&bar[XB_XCNT(b.x)], 1u);
    return b;
}
__device__ __forceinline__ void xcd_barrier_complete(GAS unsigned* bar, unsigned x, unsigned& nloc, unsigned& nx) {
    const unsigned G = gridDim.x * gridDim.y * gridDim.z;
    unsigned sum, cnt, mine, sp = 0u;
    for (;;) {
        sum = 0u; cnt = 0u; mine = 0u;
#pragma unroll
        for (unsigned j = 0; j < 16; ++j) { const unsigned c = xb_ld(&bar[XB_XCNT(j)]); sum += c; cnt += (c > 0u) ? 1u : 0u; mine = (j == x) ? c : mine; }
        if (sum == G) break;
        __builtin_amdgcn_s_sleep(1);
        if ((++sp & 255u) == 0u) { if (xb_ld(&bar[XB_TMO])) break; if (sp > XB_SPIN_CAP) { atomicAdd((unsigned*)&bar[XB_TMO], 1u); break; } }
    }
    nloc = mine > 0u ? mine : 1u; nx = cnt > 0u ? cnt : 1u;
}

__device__ __forceinline__ void xcd_barrier(const XcdBarrier& b) {
    asm volatile("s_waitcnt vmcnt(0)" ::: "memory");
    __syncthreads();
    if (threadIdx.x == 0) {
        unsigned long long bi_ = (unsigned long long)b.bar; asm volatile("" : "+s"(bi_));
        GAS unsigned* bar = (GAS unsigned*)bi_;
        __builtin_amdgcn_s_waitcnt(0);
        unsigned nloc = b.st[0], nx = b.st[1];
        if (nloc == 0u) { xcd_barrier_complete(bar, b.x, nloc, nx); b.st[0] = nloc; b.st[1] = nx; }
        const unsigned old = xb_add(&bar[XB_XSUB(b.x)], 1u);
        const unsigned gen = old / nloc;
        if (old + 1u == (gen + 1u) * nloc) {
            __builtin_amdgcn_fence(__ATOMIC_RELEASE, "agent");
            asm volatile("s_waitcnt vmcnt(0)" ::: "memory");
            const unsigned og = xb_add(&bar[XB_TOP], 1u);
            const unsigned tg = og / nx;
            if (og + 1u == (tg + 1u) * nx) xb_add(&bar[XB_TOPGEN], 1u);
            else XB_SPIN(xb_ld(&bar[XB_TOPGEN]) == tg, bar);
            __builtin_amdgcn_fence(__ATOMIC_ACQUIRE, "agent");
            xb_add(&bar[XB_XGEN(b.x)], 1u);
            asm volatile("s_waitcnt vmcnt(0)" ::: "memory");
        } else {
            XB_SPIN(xb_ld(&bar[XB_XGEN(b.x)]) == gen, bar);
            __builtin_amdgcn_fence(__ATOMIC_ACQUIRE, "agent");
            asm volatile("s_waitcnt vmcnt(0)" ::: "memory");
        }
    }
    __syncthreads();
}

struct Frame {
    LAS unsigned char* lds;
    volatile LAS unsigned* MISC;
    gu32* ctl;
    int tid, lane, wave, G;
};
struct Args { const float* in[22]; float* out; unsigned char* ws; int ph_lo, ph_hi; };
#define LAUNDER_S(p) asm volatile("" : "+s"(p))
__device__ __forceinline__ float wave_sum(float v) {
#pragma unroll
    for (int o = 1; o < 64; o <<= 1) v += __shfl_xor(v, o);
    return v;
}
enum { I_X = 0, I_N1, I_G1, I_U1, I_D1, I_NM, I_WIN, I_CAW, I_CAB, I_LAG, I_LAB, I_LVG, I_LVB, I_WS, I_BS, I_CCW, I_WOUT, I_N2, I_G2, I_U2, I_D2, I_NF };

__device__ __forceinline__ void p0_transpose_item(const float* W, int N, int K, bf16* WT, int dest_row0, const float* gain, LAS float* scr, int k0, int n0, int lane) {
    const GAS float* wp = (const GAS float*)W + (size_t)(k0 + (lane >> 5)) * N + n0 + (lane & 31);
    float v[32];
#pragma unroll
    for (int i = 0; i < 32; ++i) { v[i] = *wp; wp += 2 * N; }
    const int c = lane & 7;
    f32x4 g0 = (f32x4){1.f, 1.f, 1.f, 1.f}, g1 = g0;
    if (gain) { g0 = *(const GAS f32x4*)(gain + k0 + 8 * c); g1 = *(const GAS f32x4*)(gain + k0 + 8 * c + 4); }
#pragma unroll
    for (int i = 0; i < 32; ++i) scr[(2 * i + (lane >> 5)) * 33 + (lane & 31)] = v[i];
    LDS_WAIT(); asm volatile("" ::: "memory");
#pragma unroll
    for (int j = 0; j < 4; ++j) { const int n = (lane >> 3) + 8 * j; const LAS float* s = scr + (8 * c) * 33 + n;
        v4u o; o.x = pk2(s[0 * 33] * g0[0], s[1 * 33] * g0[1]); o.y = pk2(s[2 * 33] * g0[2], s[3 * 33] * g0[3]); o.z = pk2(s[4 * 33] * g1[0], s[5 * 33] * g1[1]); o.w = pk2(s[6 * 33] * g1[2], s[7 * 33] * g1[3]);
        *(GAS v4u*)(WT + (size_t)(dest_row0 + n) * K + k0 + 8 * c) = o; }
    LDS_WAIT(); asm volatile("" ::: "memory");
}
__device__ __forceinline__ int map_gu(int n0, int up) { return (n0 >> 7) * 256 + (n0 & 127) + (up ? 128 : 0); }
__device__ __forceinline__ int map_in(int n) {
    if (n < 384) return (n >> 7) * 256 + (n & 127);
    if (n < 768) { const int r = n - 384; return (r >> 7) * 256 + 128 + (r & 127); }
    if (n < 1280) return n;
    if (n < 1664) return 2048 + (n - 1280);
    if (n < 2048) { const int r = n - 1664; return 1280 + (r >> 7) * 256 + (r & 127); }
    { const int r = n - 2048; return 1280 + (r >> 7) * 256 + 128 + (r & 127); }
}
__device__ __forceinline__ void p0_prologue(Frame& F, const Args& A) {
    unsigned char* ws = A.ws; LAUNDER_S(ws);
    LAS float* scr = (LAS float*)(F.lds + RING_OFF + F.wave * 16384);
    const int gw = blockIdx.x * NWAVES + F.wave, NGW = F.G * NWAVES, lane = F.lane;
    constexpr int I_GU = (D / 64) * (FF / 32), I_DN = (FF / 64) * (D / 32), I_IN = (D / 64) * (DPROJ / 32), I_OUT = (D / 64) * (D / 32);
    constexpr int PER_LAYER = 4 * I_GU + 2 * I_DN + I_IN + I_OUT;
    for (int it = gw; it < DEPTH * PER_LAYER; it += NGW) {
        const int l = it / PER_LAYER; int r = it % PER_LAYER;
        unsigned char* wl = ws + WS_W + (size_t)l * W_LAYER;
        const float* W; const float* gain = nullptr; bf16* WT; int N, K, mode;
        if (r < I_GU) { W = A.in[I_G1] + (size_t)l * D * FF; gain = A.in[I_N1] + l * D; WT = (bf16*)(wl + WO_GU1); N = FF; K = D; mode = 1; }
        else if ((r -= I_GU) < I_GU) { W = A.in[I_U1] + (size_t)l * D * FF; gain = A.in[I_N1] + l * D; WT = (bf16*)(wl + WO_GU1); N = FF; K = D; mode = 2; }
        else if ((r -= I_GU) < I_DN) { W = A.in[I_D1] + (size_t)l * D * FF; WT = (bf16*)(wl + WO_D1); N = D; K = FF; mode = 0; }
        else if ((r -= I_DN) < I_IN) { W = A.in[I_WIN] + (size_t)l * D * DPROJ; gain = A.in[I_NM] + l * D; WT = (bf16*)(wl + WO_IN); N = DPROJ; K = D; mode = 3; }
        else if ((r -= I_IN) < I_OUT) { W = A.in[I_WOUT] + (size_t)l * D * D; WT = (bf16*)(wl + WO_OUT); N = D; K = D; mode = 0; }
        else if ((r -= I_OUT) < I_GU) { W = A.in[I_G2] + (size_t)l * D * FF; gain = A.in[I_N2] + l * D; WT = (bf16*)(wl + WO_GU2); N = FF; K = D; mode = 1; }
        else if ((r -= I_GU) < I_GU) { W = A.in[I_U2] + (size_t)l * D * FF; gain = A.in[I_N2] + l * D; WT = (bf16*)(wl + WO_GU2); N = FF; K = D; mode = 2; }
        else { r -= I_GU; W = A.in[I_D2] + (size_t)l * D * FF; WT = (bf16*)(wl + WO_D2); N = D; K = FF; mode = 0; }
        const int nblk = N / 32, kb = r / nblk, nb = r % nblk, k0 = 64 * kb, n0 = 32 * nb;
        const int dr = mode == 0 ? n0 : (mode == 3 ? map_in(n0) : map_gu(n0, mode == 2));
        p0_transpose_item(W, N, K, WT, dr, gain, scr, k0, n0, lane);
    }
    const int gt = blockIdx.x * (NWAVES * 64) + F.tid, NGT = F.G * NWAVES * 64;
    for (int i = gt; i < DEPTH * 128 * D / 8; i += NGT) { const int l = i / (128 * D / 8), r = i % (128 * D / 8);
        *(GAS v4u*)(ws + WS_W + (size_t)l * W_LAYER + WO_IN + (size_t)DPROJ * D * 2 + (size_t)r * 16) = (v4u){0u, 0u, 0u, 0u}; }
    for (int r = gw; r < DEPTH * 4 * 128; r += NGW) { const int l = r >> 9, rr = r & 511, t = rr & 127; float sum = 0.f;
        GAS bf16* wm = (GAS bf16*)(ws + WS_W + (size_t)l * W_LAYER + WO_S) + (size_t)rr * 128;
#pragma unroll
        for (int i = 0; i < 2; ++i) { const int sidx = lane + 64 * i; const unsigned mb = sidx <= t ? f2bf(A.in[I_WS][(size_t)r * 128 + sidx]) : 0u; wm[sidx] = (bf16)mb; sum += __uint_as_float(mb << 16); }
        sum = wave_sum(sum);
        if (lane == 0) ((GAS float*)(ws + WS_W + (size_t)l * W_LAYER + WO_RSW))[rr] = sum; }
    GAS float* rowss = (GAS float*)(ws + WS_ROWSS);
    for (int i = gt; i < 6 * M; i += NGT) rowss[M + i] = 0.f;
    const float* x = A.in[I_X]; GAS bf16* xb = (GAS bf16*)(ws + WS_XB);
    for (int m0 = gw * 4; m0 < M; m0 += NGW * 4) {
        f32x4 v[4][4]; float sq[4];
#pragma unroll
        for (int r = 0; r < 4; ++r) { const GAS f32x4* xr = (const GAS f32x4*)(x + (size_t)(m0 + r) * D) + lane;
#pragma unroll
            for (int j = 0; j < 4; ++j) v[r][j] = xr[64 * j]; }
#pragma unroll
        for (int r = 0; r < 4; ++r) { float s = 0.f;
#pragma unroll
            for (int j = 0; j < 4; ++j) s += (v[r][j].x * v[r][j].x + v[r][j].y * v[r][j].y) + (v[r][j].z * v[r][j].z + v[r][j].w * v[r][j].w);
            sq[r] = s; }
#pragma unroll
        for (int o = 1; o < 64; o <<= 1) {
#pragma unroll
            for (int r = 0; r < 4; ++r) sq[r] += __shfl_xor(sq[r], o); }
#pragma unroll
        for (int r = 0; r < 4; ++r) { GAS v2u* o8 = (GAS v2u*)(xb + (size_t)(m0 + r) * D) + lane;
#pragma unroll
            for (int j = 0; j < 4; ++j) o8[64 * j] = (v2u){pk2(v[r][j].x, v[r][j].y), pk2(v[r][j].z, v[r][j].w)}; }
        if (lane < 4) rowss[m0 + lane] = lane == 0 ? sq[0] : (lane == 1 ? sq[1] : (lane == 2 ? sq[2] : sq[3]));
    }
}

__device__ __forceinline__ void final_phase(Frame& F, const Args& A) {
    unsigned char* ws = A.ws; LAUNDER_S(ws);
    int tid_ = threadIdx.x; asm volatile("" : "+v"(tid_));
    const int gw = blockIdx.x * NWAVES + F.wave, NGW = F.G * NWAVES, lane = tid_ & 63;
    const GAS float* rowss = (const GAS float*)(ws + WS_ROWSS) + 6 * (size_t)M; const float* g = A.in[I_NF]; const GAS bf16* xb = (const GAS bf16*)(ws + WS_XB);
    f32x4 gv[4];
#pragma unroll
    for (int j = 0; j < 4; ++j) gv[j] = *((const f32x4*)g + lane + 64 * j);
    for (int m0 = gw * 4; m0 < M; m0 += NGW * 4) {
        v2u xv[4][4]; float rs[4];
#pragma unroll
        for (int r = 0; r < 4; ++r) { rs[r] = rowss[m0 + r]; const GAS v2u* xr = (const GAS v2u*)(xb + (size_t)(m0 + r) * D) + lane;
#pragma unroll
            for (int j = 0; j < 4; ++j) xv[r][j] = xr[64 * j]; }
#pragma unroll
        for (int r = 0; r < 4; ++r) { const float sc = __builtin_amdgcn_rsqf(rs[r] * (1.0f / 1024.0f) + RMS_EPS); GAS f32x4* orow = (GAS f32x4*)(A.out + (size_t)(m0 + r) * D) + lane;
#pragma unroll
            for (int j = 0; j < 4; ++j) { const f32x4 v = (f32x4){bflo(xv[r][j].x), bfhi(xv[r][j].x), bflo(xv[r][j].y), bfhi(xv[r][j].y)}; orow[64 * j] = v * sc * gv[j]; } }
    }
}

constexpr int TA_ROW = 784;
constexpr int ST_OFF = 158 * TA_ROW;
constexpr int HOLD_OFF = RING_BYTES + 2048;
constexpr int VT_STR = 132;
static_assert(ST_OFF + 1024 <= RING_BYTES && 256 * VT_STR * 2 <= RING_BYTES && HOLD_OFF + 32 * TA_ROW <= LDS_BYTES, "mixer LDS");
typedef float f32x2 __attribute__((ext_vector_type(2)));
__device__ __forceinline__ float quad_sum(float v) {
    v += __builtin_bit_cast(float, __builtin_amdgcn_update_dpp(0, __builtin_bit_cast(int, v), 0xB1, 0xF, 0xF, true));
    v += __builtin_bit_cast(float, __builtin_amdgcn_update_dpp(0, __builtin_bit_cast(int, v), 0x4E, 0xF, 0xF, true));
    return v;
}
__device__ __forceinline__ void mixer_c_item(const GAS bf16* P, GAS bf16* MX, const float* ccw, int tok0, int pos0, int it) {
    const int t = it / 48, c8 = it % 48; const int pos = pos0 + t;
    const GAS bf16* base = P + (size_t)(tok0 + t) * PACT_W;
    const v4u x0 = *(const GAS v4u*)(base + P_CX + c8 * 8); v4u x1 = (v4u){0u, 0u, 0u, 0u}, x2 = x1;
    if (pos >= 1) x1 = *(const GAS v4u*)(base - PACT_W + P_CX + c8 * 8);
    if (pos >= 2) x2 = *(const GAS v4u*)(base - 2 * PACT_W + P_CX + c8 * 8);
    const v4u cb = *(const GAS v4u*)(base + P_CB + c8 * 8);
    const f32x4 w0a = *(const f32x4*)(ccw + 0 * DC + c8 * 8), w0b = *(const f32x4*)(ccw + 0 * DC + c8 * 8 + 4);
    const f32x4 w1a = *(const f32x4*)(ccw + 1 * DC + c8 * 8), w1b = *(const f32x4*)(ccw + 1 * DC + c8 * 8 + 4);
    const f32x4 w2a = *(const f32x4*)(ccw + 2 * DC + c8 * 8), w2b = *(const f32x4*)(ccw + 2 * DC + c8 * 8 + 4);
    v4u o;
#pragma unroll
    for (int e = 0; e < 4; ++e) {
        const float wl0 = e < 2 ? w0a[2 * e] : w0b[2 * e - 4], wh0 = e < 2 ? w0a[2 * e + 1] : w0b[2 * e - 3];
        const float wl1 = e < 2 ? w1a[2 * e] : w1b[2 * e - 4], wh1 = e < 2 ? w1a[2 * e + 1] : w1b[2 * e - 3];
        const float wl2 = e < 2 ? w2a[2 * e] : w2b[2 * e - 4], wh2 = e < 2 ? w2a[2 * e + 1] : w2b[2 * e - 3];
        const float lo_ = bflo(cb[e]) * (wl0 * bflo(x2[e]) + wl1 * bflo(x1[e]) + wl2 * bflo(x0[e]));
        const float hi_ = bfhi(cb[e]) * (wh0 * bfhi(x2[e]) + wh1 * bfhi(x1[e]) + wh2 * bfhi(x0[e]));
        o[e] = pk2(lo_, hi_); }
    *(GAS v4u*)(MX + (size_t)(tok0 + t) * D + MIX_C + c8 * 8) = o;
}
__device__ __forceinline__ void mixer_phase(Frame& F, const Args& A, int l) {
    unsigned char* ws = A.ws; LAUNDER_S(ws);
    int tid_ = threadIdx.x; asm volatile("" : "+v"(tid_)); const int tid = tid_, lane = tid & 63, wave = F.wave;
    const GAS bf16* P = (const GAS bf16*)(ws + WS_PACT); GAS bf16* MX = (GAS bf16*)(ws + WS_MIX);
    const float* caw = A.in[I_CAW] + l * 31 * DA; const float* cab = A.in[I_CAB] + l * DA;
    const float* lag = A.in[I_LAG] + l * DA; const float* lab = A.in[I_LAB] + l * DA;
    const float* lvg = A.in[I_LVG] + l * DB; const float* lvb = A.in[I_LVB] + l * DB;
    const float* bs = A.in[I_BS] + l * 4 * CHUNK; const float* ccw = A.in[I_CCW] + l * 3 * DC;
    const GAS bf16* Wm = (const GAS bf16*)(ws + WS_W + (size_t)l * W_LAYER + WO_S);
    const GAS float* RSW = (const GAS float*)(ws + WS_W + (size_t)l * W_LAYER + WO_RSW);
    LAS unsigned char* T = F.lds + RING_OFF;
    LAS f32x2* ST = (LAS f32x2*)(T + ST_OFF);
    for (int q = blockIdx.x; q < NCHUNK; q += F.G) {
        const int tok0 = q * CHUNK; const int pos0 = (q & 15) * CHUNK;
        for (int p = tid; p < 158 * 48; p += NWAVES * 64) { const int j = p / 48, c8 = p % 48; v4u v = (v4u){0u, 0u, 0u, 0u};
            if (pos0 + j >= 30) v = *(const GAS v4u*)(P + (size_t)(tok0 - 30 + j) * PACT_W + P_GLU + c8 * 8);
            *(LAS v4u*)(T + j * TA_ROW + c8 * 16) = v; }
        __syncthreads();
        if (wave < 6) {
            const int half = wave >= 3 ? 1 : 0, p = tid - half * 192; f32x2 w2[31];
#pragma unroll
            for (int k = 0; k < 31; ++k) w2[k] = *(const f32x2*)(caw + k * DA + 2 * p);
            const f32x2 bias2 = *(const f32x2*)(cab + 2 * p);
            LAS unsigned char* colp = T + 4 * p;
#define CONV_LOOP(NB, RD, WR) do { LAS unsigned char* rd_ = (RD); LAS unsigned char* wr_ = (WR); \
                _Pragma("unroll 1") for (int tb = 0; tb < (NB); ++tb, rd_ += 4 * TA_ROW, wr_ += 4 * TA_ROW) { f32x2 in2[34]; \
                    _Pragma("unroll") for (int i = 0; i < 34; ++i) { const unsigned wd = *(const LAS unsigned*)(rd_ + i * TA_ROW); in2[i] = (f32x2){bflo(wd), bfhi(wd)}; } \
                    _Pragma("unroll") for (int i = 0; i < 4; ++i) { f32x2 o = bias2; _Pragma("unroll") for (int k = 0; k < 31; ++k) o = w2[k] * in2[i + k] + o; *(LAS unsigned*)(wr_ + i * TA_ROW) = pk2(o.x, o.y); } } } while (0)
            if (half == 0) { CONV_LOOP(16, colp, colp); }
            else { CONV_LOOP(8, colp + 64 * TA_ROW, F.lds + HOLD_OFF + 4 * p); CONV_LOOP(8, colp + 96 * TA_ROW, colp + 96 * TA_ROW); }
#undef CONV_LOOP
        }
        for (int v = (wave >= 6 ? 0 : 32); v < 36; ++v) { const int it = v < 32 ? (tid - 6 * 64) + 128 * v : 4096 + tid + NWAVES * 64 * (v - 32);
            mixer_c_item(P, MX, ccw, tok0, pos0, it); }
        __syncthreads();
        {
            const int t = tid >> 2, qq = tid & 3; const LAS unsigned char* rp = ((t >= 64 && t < 96) ? (F.lds + HOLD_OFF + (t - 64) * TA_ROW) : (T + t * TA_ROW)) + qq * 192; float s = 0.f, s2 = 0.f;
#pragma unroll
            for (int j = 0; j < 12; ++j) { const v4u d = *(const LAS v4u*)(rp + 16 * j);
#pragma unroll
                for (int e = 0; e < 4; ++e) { const float lo = bflo(d[e]), hi = bfhi(d[e]); s += lo + hi; s2 += lo * lo + hi * hi; } }
            s = quad_sum(s); s2 = quad_sum(s2);
            const float mean = s * (1.0f / DA), var = s2 * (1.0f / DA) - mean * mean;
            if (qq == 0) ST[t] = (f32x2){mean, __builtin_amdgcn_rsqf(fmaxf(var, 0.f) + LN_EPS)};
        }
        __syncthreads();
        {
            float g6[6], b6[6];
#pragma unroll
            for (int j = 0; j < 3; ++j) { const f32x2 gg = *(const f32x2*)(lag + 2 * lane + 128 * j), bb = *(const f32x2*)(lab + 2 * lane + 128 * j); g6[2 * j] = gg.x; g6[2 * j + 1] = gg.y; b6[2 * j] = bb.x; b6[2 * j + 1] = bb.y; }
#pragma unroll 4
            for (int tt = 0; tt < 16; ++tt) { const int t = wave * 16 + tt; const f32x2 st = ST[t]; const LAS unsigned char* rowp = (t >= 64 && t < 96) ? (F.lds + HOLD_OFF + (t - 64) * TA_ROW) : (T + t * TA_ROW);
#pragma unroll
                for (int j = 0; j < 3; ++j) { const unsigned wd = *(const LAS unsigned*)(rowp + 4 * lane + 256 * j);
                    const float y0 = (bflo(wd) - st.x) * st.y * g6[2 * j] + b6[2 * j], y1 = (bfhi(wd) - st.x) * st.y * g6[2 * j + 1] + b6[2 * j + 1];
                    *(GAS unsigned*)(MX + (size_t)(tok0 + t) * D + MIX_A + 2 * lane + 128 * j) = pk2(y0 * sigm(y0), y1 * sigm(y1)); }
            }
        }
        v4u xv[8];
        {   const int t = tid >> 2, qq = tid & 3; const GAS bf16* vr = P + (size_t)(tok0 + t) * PACT_W + P_GV + qq * 64;
#pragma unroll
            for (int j = 0; j < 8; ++j) xv[j] = *(const GAS v4u*)(vr + 8 * j); }
        __syncthreads();
        {
            const int t = tid >> 2, qq = tid & 3; float s = 0.f, s2 = 0.f;
#pragma unroll
            for (int j = 0; j < 8; ++j)
#pragma unroll
                for (int e = 0; e < 4; ++e) { const float lo = bflo(xv[j][e]), hi = bfhi(xv[j][e]); s += lo + hi; s2 += lo * lo + hi * hi; }
            s = quad_sum(s); s2 = quad_sum(s2);
            const float mean = s * (1.0f / DB), rstd = __builtin_amdgcn_rsqf(fmaxf(s2 * (1.0f / DB) - mean * mean, 0.f) + LN_EPS);
            LAS unsigned short* Vt = (LAS unsigned short*)T + (qq * 64) * VT_STR + t;
#pragma unroll
            for (int j = 0; j < 8; ++j)
#pragma unroll
                for (int e = 0; e < 4; ++e) { Vt[(8 * j + 2 * e) * VT_STR] = (unsigned short)f2bf((bflo(xv[j][e]) - mean) * rstd); Vt[(8 * j + 2 * e + 1) * VT_STR] = (unsigned short)f2bf((bfhi(xv[j][e]) - mean) * rstd); }
        }
        const int fr = lane & 15, fq = lane >> 4, trow = 16 * wave + fr, nks = (16 * wave + 15) / 32 + 1;
        bf16x8 wf[4][4];
#pragma unroll
        for (int h = 0; h < 4; ++h)
#pragma unroll
            for (int ks = 0; ks < 4; ++ks) { wf[h][ks] = (bf16x8){0, 0, 0, 0, 0, 0, 0, 0}; if (ks < nks) wf[h][ks] = *(const GAS bf16x8*)(Wm + ((size_t)(h * CHUNK + trow) * CHUNK + 32 * ks + 8 * fq)); }
        __syncthreads();
        {
            const LAS unsigned short* Vt = (const LAS unsigned short*)T;
            const size_t tok = (size_t)(tok0 + trow);
#pragma unroll
            for (int h = 0; h < 4; ++h) {
                f32x4 acc[4];
#pragma unroll
                for (int nt = 0; nt < 4; ++nt) acc[nt] = (f32x4){0.f, 0.f, 0.f, 0.f};
#pragma unroll
                for (int ks = 0; ks < 4; ++ks) if (ks < nks) {
#pragma unroll
                    for (int nt = 0; nt < 4; ++nt) { const LAS unsigned short* vp = Vt + (h * 64 + nt * 16 + fr) * VT_STR + 32 * ks + 8 * fq;
                        const s16x4 v0 = *(const LAS s16x4*)vp, v1 = *(const LAS s16x4*)(vp + 4);
                        const bf16x8 vf = __builtin_shufflevector(v0, v1, 0, 1, 2, 3, 4, 5, 6, 7);
                        acc[nt] = __builtin_amdgcn_mfma_f32_16x16x32_bf16(vf, wf[h][ks], acc[nt], 0, 0, 0); }
                }
                const float bsv = bs[h * CHUNK + trow], rsw = RSW[h * CHUNK + trow];
#pragma unroll
                for (int nt = 0; nt < 4; ++nt) { const int d0 = h * 64 + nt * 16 + 4 * fq;
                    const v2u gu = *(const GAS v2u*)(P + tok * PACT_W + P_GU + d0);
                    const f32x4 gg = *(const f32x4*)(lvg + d0), bb = *(const f32x4*)(lvb + d0);
                    const float o0 = bflo(gu.x) * (gg[0] * acc[nt][0] + bb[0] * rsw + bsv), o1 = bfhi(gu.x) * (gg[1] * acc[nt][1] + bb[1] * rsw + bsv);
                    const float o2 = bflo(gu.y) * (gg[2] * acc[nt][2] + bb[2] * rsw + bsv), o3 = bfhi(gu.y) * (gg[3] * acc[nt][3] + bb[3] * rsw + bsv);
                    *(GAS v2u*)(MX + tok * D + MIX_B + d0) = (v2u){pk2(o0, o1), pk2(o2, o3)}; }
            }
        }
        __syncthreads();
    }
}

__global__ void __launch_bounds__(NWAVES * 64, 2) hybrid_fwd(Args args) {
    extern __shared__ __attribute__((aligned(16))) unsigned char lds[];
    if (args.ph_hi > N_PHASES) cg::this_grid().sync();
    Frame F;
    F.lds = (LAS unsigned char*)lds;
    F.MISC = (volatile LAS unsigned*)(F.lds + MISC_OFF);
    F.tid = threadIdx.x; F.lane = F.tid & 63; F.wave = __builtin_amdgcn_readfirstlane(F.tid >> 6);
    F.G = gridDim.x;
    F.ctl = (gu32*)(args.ws + WS_CTL);
    for (int u = F.tid; u < (LDS_BYTES - LDSCTL_OFF) / 4; u += NWAVES * 64) ((LAS unsigned*)(F.lds + LDSCTL_OFF))[u] = 0u;
    __syncthreads();
    const int lo = args.ph_lo, hi = args.ph_hi;
    const bool multi = (hi - lo) > 1;
    XcdBarrier bar; bar.bar = (unsigned*)(F.ctl + CW_BAR); bar.x = 0; bar.st = nullptr;
    if (multi && !MK_CG_SYNC) bar = xcd_barrier_post((unsigned*)(F.ctl + CW_BAR), F.MISC + 8);
#define IN(k) (lo <= (k) && (k) < hi)
#define BOTH(k) (IN(k) && IN((k) + 1))
#define SEAM(k) do { if (BOTH(k)) { if (MK_CG_SYNC) cg::this_grid().sync(); else xcd_barrier(bar); } } while (0)
#define PHASE_PTRS() unsigned char* ws = args.ws; LAUNDER_S(ws); float* rowss = (float*)(ws + WS_ROWSS); unsigned char* wl = ws + WS_W + (size_t)l * W_LAYER; (void)rowss; (void)wl

    if (IN(0)) { for (int rep = 0; rep <= PROBE_PRO; ++rep) p0_prologue(F, args); SEAM(0); }
#pragma unroll 1
    for (int l = 0; l < DEPTH; ++l) {
        const int pb = 1 + 7 * l;
        if (IN(pb + 0)) {
            PHASE_PTRS();
            pg8::Gemm g{(const bf16*)(ws + WS_XB), (const bf16*)(wl + WO_GU1), M, NGU, D}; pg8::StaticOrder S; S.init(M, NGU, F.G, (int)blockIdx.x);
            pg8::EpiSwiGLU E{(bf16*)(ws + WS_HID), rowss + (size_t)(3 * l) * M, FF, (LAS float*)(F.lds + RSTBL_OFF)};
            for (int rep = 0; rep <= PROBE_GU; ++rep) { pg8::gemm_phase<pg8::EpiSwiGLU, pg8::StaticOrder, PG8_ALIGN, PG8_SP2>(F.lds + RING_OFF, g, S, E); }
            for (int rep = 0; rep < PROBE_NULLGU; ++rep) { pg8::EpiNull EN; pg8::gemm_phase<pg8::EpiNull, pg8::StaticOrder, PG8_ALIGN, PG8_SP2>(F.lds + RING_OFF, g, S, EN); }
            SEAM(pb + 0);
        }
        if (IN(pb + 1)) {
            PHASE_PTRS();
            pg8::Gemm g{(const bf16*)(ws + WS_HID), (const bf16*)(wl + WO_D1), M, D, FF}; pg8::StaticOrder S; S.init(M, D, F.G, (int)blockIdx.x);
            pg8::EpiResid E{(bf16*)(ws + WS_XB), rowss + (size_t)(3 * l + 1) * M, 0.5f, 1};
            for (int rep = PROBE_D; rep >= 0; --rep) { E.live = (rep == 0); pg8::gemm_phase<pg8::EpiResid, pg8::StaticOrder, PG8_ALIGN, PG8_SP2>(F.lds + RING_OFF, g, S, E); }
            SEAM(pb + 1);
        }
        if (IN(pb + 2)) {
            PHASE_PTRS();
            pg8::Gemm g{(const bf16*)(ws + WS_XB), (const bf16*)(wl + WO_IN), M, NIN, D}; pg8::StaticOrder S; S.init(M, NIN, F.G, (int)blockIdx.x);
            pg8::EpiIn E{(bf16*)(ws + WS_PACT), rowss + (size_t)(3 * l + 1) * M, (LAS float*)(F.lds + RSTBL_OFF)};
            for (int rep = 0; rep <= PROBE_IN; ++rep) { pg8::gemm_phase<pg8::EpiIn, pg8::StaticOrder, PG8_ALIGN, PG8_SP2>(F.lds + RING_OFF, g, S, E); }
            SEAM(pb + 2);
        }
        if (IN(pb + 3)) { for (int rep = 0; rep <= PROBE_MIX; ++rep) mixer_phase(F, args, l); SEAM(pb + 3); }
        if (IN(pb + 4)) {
            PHASE_PTRS();
            pg8::Gemm g{(const bf16*)(ws + WS_MIX), (const bf16*)(wl + WO_OUT), M, D, D}; pg8::StaticOrder S; S.init(M, D, F.G, (int)blockIdx.x);
            pg8::EpiResid E{(bf16*)(ws + WS_XB), rowss + (size_t)(3 * l + 2) * M, 1.0f, 1};
            for (int rep = PROBE_OUT; rep >= 0; --rep) { E.live = (rep == 0); pg8::gemm_phase<pg8::EpiResid, pg8::StaticOrder, PG8_ALIGN, PG8_SP2>(F.lds + RING_OFF, g, S, E); }
            SEAM(pb + 4);
        }
        if (IN(pb + 5)) {
            PHASE_PTRS();
            pg8::Gemm g{(const bf16*)(ws + WS_XB), (const bf16*)(wl + WO_GU2), M, NGU, D}; pg8::StaticOrder S; S.init(M, NGU, F.G, (int)blockIdx.x);
            pg8::EpiSwiGLU E{(bf16*)(ws + WS_HID), rowss + (size_t)(3 * l + 2) * M, FF, (LAS float*)(F.lds + RSTBL_OFF)};
            for (int rep = 0; rep <= PROBE_GU; ++rep) { pg8::gemm_phase<pg8::EpiSwiGLU, pg8::StaticOrder, PG8_ALIGN, PG8_SP2>(F.lds + RING_OFF, g, S, E); }
            SEAM(pb + 5);
        }
        if (IN(pb + 6)) {
            PHASE_PTRS();
            pg8::Gemm g{(const bf16*)(ws + WS_HID), (const bf16*)(wl + WO_D2), M, D, FF}; pg8::StaticOrder S; S.init(M, D, F.G, (int)blockIdx.x);
            pg8::EpiResid E{(bf16*)(ws + WS_XB), rowss + (size_t)(3 * l + 3) * M, 0.5f, 1};
            for (int rep = PROBE_D; rep >= 0; --rep) { E.live = (rep == 0); pg8::gemm_phase<pg8::EpiResid, pg8::StaticOrder, PG8_ALIGN, PG8_SP2>(F.lds + RING_OFF, g, S, E); }
            SEAM(pb + 6);
        }
    }
    if (IN(15)) { for (int rep = 0; rep <= PROBE_FIN; ++rep) final_phase(F, args); }
#undef IN
#undef BOTH
#undef SEAM
#undef PHASE_PTRS
}

extern "C" void kernel_launch(void* const* d_in, const int* in_sizes, int n_in, void* d_out, int out_size, void* d_ws, size_t ws_size, hipStream_t stream) {
    static int grid = 0;
    if (grid == 0) {
        if (n_in != 22 || in_sizes[0] != M * D || out_size != M * D || ws_size < WS_END) { fprintf(stderr, "kernel_launch: shape/workspace mismatch (n_in %d in0 %d out %d ws %zu)\n", n_in, n_in > 0 ? in_sizes[0] : -1, out_size, ws_size); grid = -1; return; }
        int dev = 0, cus = 0, per_cu = 0;
        if (hipGetDevice(&dev) != hipSuccess || hipDeviceGetAttribute(&cus, hipDeviceAttributeMultiprocessorCount, dev) != hipSuccess) { grid = -1; return; }
        if (hipFuncSetAttribute((const void*)hybrid_fwd, hipFuncAttributeMaxDynamicSharedMemorySize, LDS_BYTES) != hipSuccess) { fprintf(stderr, "kernel_launch: hipFuncSetAttribute failed\n"); grid = -1; return; }
        if (hipOccupancyMaxActiveBlocksPerMultiprocessor(&per_cu, (const void*)hybrid_fwd, NWAVES * 64, LDS_BYTES) != hipSuccess || per_cu < 1) { fprintf(stderr, "kernel_launch: occupancy query says %d blocks per CU\n", per_cu); per_cu = 1; }
        (void)hipGetLastError();
        grid = cus * 1;
    }
    if (grid < 0) return;
    (void)hipMemsetAsync((char*)d_ws + WS_CTL, 0, CTL_ZERO_BYTES, stream);
    Args a{};
    for (int i = 0; i < 22; ++i) a.in[i] = (const float*)d_in[i];
    a.out = (float*)d_out; a.ws = (unsigned char*)d_ws;
#if MK_N_LAUNCHES == 1
    a.ph_lo = 0; a.ph_hi = N_PHASES;
    void* kargs[] = {&a};
    hipError_t e = hipLaunchCooperativeKernel((const void*)hybrid_fwd, dim3(grid), dim3(NWAVES * 64), kargs, LDS_BYTES, stream);
    if (e != hipSuccess) fprintf(stderr, "kernel_launch: cooperative launch failed: %s (grid %d)\n", hipGetErrorString(e), grid);
#else
    for (int p = 0; p < N_PHASES; ++p) { a.ph_lo = p; a.ph_hi = p + 1;
        hipLaunchKernelGGL(hybrid_fwd, dim3(grid), dim3(NWAVES * 64), LDS_BYTES, stream, a); }
#endif
}
```
